# Optimizing an MI355X kernel written in HIP

```python
import math
import jax, jax.numpy as jnp
from jax import lax
import numpy as np

D_MODEL = 1024
BATCH = 1
SEQ = 16384
DEPTH = 2

ATT_HEADS = 8
ATT_KV_HEADS = 2
ATT_HEAD_DIM = 64
ATT_BLOCK = 128
ATT_WINDOW = 128
CONV_WIDTH = 512
CONV_KSIZE = 3
GLA_HEADS = 4
GLA_KEY_DIM = 256
GLA_VALUE_DIM = 512
GLA_GATE_RANK = 16
GLA_TAU = 16.0
GLA_CHUNK = 16
N_BRANCHES = 3
N_EXPERTS = 16
EXPERT_FF = 2048
CAPACITY_FACTOR = 2
DN_ALPHA = (2 * DEPTH) ** 0.25
DN_BETA = (8 * DEPTH) ** -0.25
LN_EPS = 1e-5
RMS_EPS = 1e-6

SPLIT_SIZES = (
    ATT_HEADS * ATT_HEAD_DIM,
    ATT_KV_HEADS * ATT_HEAD_DIM,
    ATT_KV_HEADS * ATT_HEAD_DIM,
    CONV_WIDTH,
    CONV_WIDTH,
    CONV_WIDTH,
    GLA_KEY_DIM,
    GLA_KEY_DIM,
    GLA_VALUE_DIM,
    GLA_VALUE_DIM,
    2 * GLA_GATE_RANK,
    N_BRANCHES * D_MODEL,
)
N_IN = int(sum(SPLIT_SIZES))
SPLIT_POINTS = [int(v) for v in np.cumsum(SPLIT_SIZES)[:-1]]

kernel_name = "hybrid_swa_conv_gla_ec_moe_deepnorm"


def layer_norm(x, g, b):
    xf = x.astype(jnp.float32)
    mu = jnp.mean(xf, axis=-1, keepdims=True)
    var = jnp.mean(jnp.square(xf - mu), axis=-1, keepdims=True)
    return ((xf - mu) * lax.rsqrt(var + LN_EPS) * g.astype(jnp.float32) + b.astype(jnp.float32)).astype(x.dtype)


def window_attention(q, k, v, sink):
    B, S = q.shape[0], q.shape[1]
    nb = S // ATT_BLOCK
    G = ATT_HEADS // ATT_KV_HEADS
    qb = q.reshape(B, nb, ATT_BLOCK, ATT_KV_HEADS, G, ATT_HEAD_DIM)

    def neighbourhood(t):
        tp = jnp.pad(t, ((0, 0), (ATT_BLOCK, ATT_BLOCK), (0, 0), (0, 0)))
        tp = tp.reshape(B, nb + 2, ATT_BLOCK, ATT_KV_HEADS, ATT_HEAD_DIM)
        return jnp.concatenate([tp[:, :-2], tp[:, 1:-1], tp[:, 2:]], axis=2)

    kw, vw = neighbourhood(k), neighbourhood(v)
    s = jnp.einsum('bnqhgd,bnkhd->bnhgqk', qb, kw).astype(jnp.float32) * (ATT_HEAD_DIM ** -0.5)
    q_off = jnp.arange(ATT_BLOCK)
    k_off = jnp.arange(3 * ATT_BLOCK) - ATT_BLOCK
    dist = jnp.abs(q_off[:, None] - k_off[None, :]).astype(jnp.float32)
    k_abs = jnp.arange(nb)[:, None] * ATT_BLOCK + k_off[None, :]
    valid = (dist <= ATT_WINDOW)[None] & ((k_abs >= 0) & (k_abs < S))[:, None, :]
    slopes = (2.0 ** (-8.0 * jnp.arange(1, ATT_HEADS + 1, dtype=jnp.float32) / ATT_HEADS)).reshape(ATT_KV_HEADS, G)
    s = s - slopes[:, :, None, None] * dist
    s = jnp.where(valid[None, :, None, None], s, -jnp.inf)
    sink_l = sink.astype(jnp.float32).reshape(ATT_KV_HEADS, G)[:, :, None, None]
    m = jnp.maximum(jnp.max(s, axis=-1, keepdims=True), sink_l)
    p = jnp.exp(s - m)
    p = p / (jnp.sum(p, axis=-1, keepdims=True) + jnp.exp(sink_l - m))
    o = jnp.einsum('bnhgqk,bnkhd->bnqhgd', p.astype(v.dtype), vw)
    return o.reshape(B, S, ATT_HEADS * ATT_HEAD_DIM)


def short_conv(h, b_gate, c_gate, w):
    u = c_gate * h
    y = lax.conv_general_dilated(
        u, w[:, None, :].astype(u.dtype), window_strides=(1,), padding=[(CONV_KSIZE // 2, CONV_KSIZE // 2)],
        dimension_numbers=('NWC', 'WIO', 'NWC'), feature_group_count=CONV_WIDTH)
    return b_gate * y


def gla_direction(q, k, v, log_a):
    f32 = jnp.float32
    B, S, H, dk = q.shape
    dv = v.shape[-1]
    C = GLA_CHUNK
    nc = S // C
    qc = q.astype(f32).reshape(B, nc, C, H, dk)
    kc = k.astype(f32).reshape(B, nc, C, H, dk)
    vc = v.astype(f32).reshape(B, nc, C, H, dv)
    b = jnp.cumsum(log_a.astype(f32).reshape(B, nc, C, H, dk), axis=2)
    lower = jnp.tril(jnp.ones((C, C), dtype=bool))[:, :, None, None]
    diff = b[:, :, :, None] - b[:, :, None, :]
    decay = jnp.exp(jnp.where(lower, diff, -jnp.inf))
    scores = jnp.einsum('bnthd,bnshd,bntshd->bnhts', qc, kc, decay)
    o_intra = jnp.einsum('bnhts,bnshv->bnthv', scores, vc)
    b_last = b[:, :, -1]
    kv = jnp.einsum('bnshd,bnshv->bnhdv', kc * jnp.exp(b_last[:, :, None] - b), vc)
    a_chunk = jnp.exp(b_last)

    def step(state, inp):
        a_n, kv_n = inp
        return a_n[..., None] * state + kv_n, state

    _, states = lax.scan(step, jnp.zeros((B, H, dk, dv), f32),
                         (jnp.moveaxis(a_chunk, 1, 0), jnp.moveaxis(kv, 1, 0)))
    states = jnp.moveaxis(states, 0, 1)
    o_inter = jnp.einsum('bnthd,bnhdv->bnthv', qc * jnp.exp(b), states)
    return (o_intra + o_inter).reshape(B, S, H, dv)


def gla_mixer(q, k, v, r, lr, w2, bias, norm_g):
    B, S = q.shape[0], q.shape[1]
    dk = GLA_KEY_DIM // GLA_HEADS
    dv = GLA_VALUE_DIM // GLA_HEADS
    qh = q.reshape(B, S, GLA_HEADS, dk) * (dk ** -0.5)
    kh = k.reshape(B, S, GLA_HEADS, dk)
    vh = v.reshape(B, S, GLA_HEADS, dv)
    z = jnp.einsum('bsir,irk->bsik', lr.reshape(B, S, 2, GLA_GATE_RANK), w2) + bias
    log_a = (jax.nn.log_sigmoid(z.astype(jnp.float32)) / GLA_TAU).reshape(B, S, 2, GLA_HEADS, dk)
    flip = lambda t: jnp.flip(t, axis=1)
    o_f = gla_direction(qh, kh, vh, log_a[:, :, 0])
    o_b = flip(gla_direction(flip(qh), flip(kh), flip(vh), flip(log_a[:, :, 1])))
    o = o_f + o_b
    o = o * lax.rsqrt(jnp.mean(o * o, axis=-1, keepdims=True) + RMS_EPS)
    o = o.reshape(B, S, GLA_VALUE_DIM) * norm_g.astype(jnp.float32)
    return (o * jax.nn.silu(r.astype(jnp.float32))).astype(r.dtype)


def expert_choice_ffn(x, router_w, w_gate, w_up, w_down):
    B, S, D = x.shape
    cap = CAPACITY_FACTOR * S // N_EXPERTS
    aff = jax.nn.softmax(jnp.einsum('bsd,de->bse', x, router_w).astype(jnp.float32), axis=-1)
    gate, idx = lax.top_k(jnp.swapaxes(aff, 1, 2), cap)
    xs = jax.vmap(lambda xb, ib: xb[ib])(x, idx)
    h = jax.nn.silu(jnp.einsum('becd,edf->becf', xs, w_gate)) * jnp.einsum('becd,edf->becf', xs, w_up)
    y = jnp.einsum('becf,efd->becd', h, w_down) * gate[..., None].astype(x.dtype)
    return jax.vmap(lambda ib, yb: jnp.zeros((S, D), yb.dtype).at[ib.reshape(-1)].add(yb.reshape(-1, D)))(idx, y)


def setup_inputs(seed: int = 0) -> dict:
    key = jax.random.key(seed)
    ks = jax.random.split(key, 20)
    L, D = DEPTH, D_MODEL
    nrm = lambda k, shape, scale: jax.random.normal(k, shape, jnp.float32) * scale
    return {
        "x": nrm(ks[0], (BATCH, SEQ, D), 1.0),
        "w_in": nrm(ks[1], (L, D, N_IN), D ** -0.5),
        "attn_sink": nrm(ks[2], (L, ATT_HEADS), 0.5),
        "conv_w": nrm(ks[3], (L, CONV_KSIZE, CONV_WIDTH), CONV_KSIZE ** -0.5),
        "gla_gate_w2": nrm(ks[4], (L, 2, GLA_GATE_RANK, GLA_KEY_DIM), GLA_GATE_RANK ** -0.5),
        "gla_gate_b": nrm(ks[5], (L, 2, GLA_KEY_DIM), 0.1),
        "gla_norm_g": 1.0 + nrm(ks[6], (L, GLA_VALUE_DIM), 0.02),
        "w_branch_attn": nrm(ks[7], (L, ATT_HEADS * ATT_HEAD_DIM, D), DN_BETA * (ATT_HEADS * ATT_HEAD_DIM) ** -0.5),
        "w_branch_conv": nrm(ks[8], (L, CONV_WIDTH, D), DN_BETA * CONV_WIDTH ** -0.5),
        "w_branch_gla": nrm(ks[9], (L, GLA_VALUE_DIM, D), DN_BETA * GLA_VALUE_DIM ** -0.5),
        "w_out": nrm(ks[10], (L, D, D), DN_BETA * D ** -0.5),
        "ln_mix_g": 1.0 + nrm(ks[11], (L, D), 0.02),
        "ln_mix_b": nrm(ks[12], (L, D), 0.02),
        "router_w": nrm(ks[13], (L, D, N_EXPERTS), D ** -0.5),
        "expert_w_gate": nrm(ks[14], (L, N_EXPERTS, D, EXPERT_FF), D ** -0.5),
        "expert_w_up": nrm(ks[15], (L, N_EXPERTS, D, EXPERT_FF), D ** -0.5),
        "expert_w_down": nrm(ks[16], (L, N_EXPERTS, EXPERT_FF, D), DN_BETA * EXPERT_FF ** -0.5),
        "ln_ffn_g": 1.0 + nrm(ks[17], (L, D), 0.02),
        "ln_ffn_b": nrm(ks[18], (L, D), 0.02),
    }


def reference(x, w_in, attn_sink, conv_w, gla_gate_w2, gla_gate_b, gla_norm_g,
              w_branch_attn, w_branch_conv, w_branch_gla, w_out, ln_mix_g, ln_mix_b,
              router_w, expert_w_gate, expert_w_up, expert_w_down, ln_ffn_g, ln_ffn_b):
    B, S, _ = x.shape
    for l in range(DEPTH):
        proj = jnp.einsum('bsd,dn->bsn', x, w_in[l])
        (aq, ak, av, ch, cb, cc, gq, gk, gv, gr, glr, mg) = jnp.split(proj, SPLIT_POINTS, axis=-1)
        y_attn = window_attention(aq.reshape(B, S, ATT_HEADS, ATT_HEAD_DIM),
                                  ak.reshape(B, S, ATT_KV_HEADS, ATT_HEAD_DIM),
                                  av.reshape(B, S, ATT_KV_HEADS, ATT_HEAD_DIM), attn_sink[l])
        y_conv = short_conv(ch, cb, cc, conv_w[l])
        y_gla = gla_mixer(gq, gk, gv, gr, glr, gla_gate_w2[l], gla_gate_b[l], gla_norm_g[l])
        g = jax.nn.sigmoid(mg.reshape(B, S, N_BRANCHES, D_MODEL))
        merged = (g[:, :, 0] * (y_attn @ w_branch_attn[l])
                  + g[:, :, 1] * (y_conv @ w_branch_conv[l])
                  + g[:, :, 2] * (y_gla @ w_branch_gla[l]))
        x = layer_norm(DN_ALPHA * x + merged @ w_out[l], ln_mix_g[l], ln_mix_b[l])
        ffn = expert_choice_ffn(x, router_w[l], expert_w_gate[l], expert_w_up[l], expert_w_down[l])
        x = layer_norm(DN_ALPHA * x + ffn, ln_ffn_g[l], ln_ffn_b[l])
    return x
```

```cpp
#include <hip/hip_runtime.h>
#include <hip/hip_cooperative_groups.h>
#include <cstdio>
namespace cg = cooperative_groups;

#ifndef ONE_LAUNCH
#define ONE_LAUNCH 1
#endif

#define LAS __attribute__((address_space(3)))
typedef unsigned short bf16_t;
typedef short bf16x8 __attribute__((ext_vector_type(8)));
typedef float f32x4 __attribute__((ext_vector_type(4)));
typedef float f32x2 __attribute__((ext_vector_type(2)));
typedef unsigned u32x4 __attribute__((ext_vector_type(4)));
typedef unsigned u32x2 __attribute__((ext_vector_type(2)));

namespace {
constexpr int SEQ = 16384, DM = 1024, NIN = 6944, NP = 7168, NL = 2;
constexpr int MG = 0, AQ = 3072, AK = 3584, AV = 3712, CH = 3840, CB = 4352, CC = 4864, GQ = 5376, GK = 5632, GV = 5888, GR = 6400, GLR = 6912;
constexpr int NE = 16, FF = 2048, CAP = 2048, NSLOT = NE * CAP;
constexpr int KCAT = 1536;
constexpr float ALPHA = 1.41421356237309515f;
constexpr int NSEG = 64, SEGLEN = 256;
constexpr int NTHREADS = 512;
constexpr int LDS_BYTES = 131072;

constexpr size_t al(size_t x) { return (x + 4095) & ~(size_t)4095; }
constexpr size_t WS_WIN = 4096;
constexpr size_t WS_WMRG = WS_WIN + al((size_t)NL * NP * 1024 * 2);
constexpr size_t WS_WOUT = WS_WMRG + al((size_t)NL * 1024 * KCAT * 2);
constexpr size_t WS_WG = WS_WOUT + al((size_t)NL * 1024 * 1024 * 2);
constexpr size_t WS_WU = WS_WG + al((size_t)NL * NE * FF * 1024 * 2);
constexpr size_t WS_WD = WS_WU + al((size_t)NL * NE * FF * 1024 * 2);
constexpr size_t WS_XB = WS_WD + al((size_t)NL * NE * FF * 1024 * 2);
constexpr size_t WS_XA = WS_XB + al((size_t)SEQ * DM * 2);
constexpr size_t WS_PROJ = WS_XA + al((size_t)SEQ * DM * 4);
constexpr size_t WS_H = WS_PROJ;
constexpr size_t WS_YB = WS_PROJ + (size_t)NSLOT * FF * 2;
constexpr size_t WS_YCAT = WS_PROJ + al((size_t)SEQ * NP * 2);
constexpr size_t WS_MERGED = WS_YCAT + al((size_t)SEQ * KCAT * 2);
constexpr size_t WS_AFF = WS_MERGED + al((size_t)SEQ * DM * 2);
constexpr size_t WS_IDX = WS_AFF + al((size_t)NE * SEQ * 4);
constexpr size_t WS_GATEV = WS_IDX + al((size_t)NSLOT * 4);
constexpr size_t WS_SLOTOF = WS_GATEV + al((size_t)NSLOT * 4);
constexpr size_t WS_GE = WS_SLOTOF + al((size_t)SEQ * NE * 4);
constexpr size_t WS_GSIN = WS_GE + al((size_t)NSEG * 2 * 32768 * 4);
constexpr size_t WS_GASEG = WS_GSIN + al((size_t)NSEG * 2 * 32768 * 4);
constexpr size_t WS_OF = WS_GASEG + al((size_t)NSEG * 2 * 256 * 4);
constexpr size_t WS_OF2 = WS_OF + al((size_t)SEQ * 512 * 4);
constexpr size_t WS_GT = WS_OF2 + al((size_t)SEQ * 512 * 4);
constexpr size_t WS_END = WS_GT + al((size_t)3 * 64 * 4 * 16 * 512 * 16);
static_assert((size_t)NSLOT * FF * 2 + (size_t)NSLOT * DM * 2 <= (size_t)SEQ * NP * 2, "H + YB must fit in PROJ");
static_assert(WS_END <= (size_t)1073741824, "workspace map must fit 4 x the largest input tensor (1 GiB)");

struct Params {
    const float* x; const float* w_in; const float* attn_sink; const float* conv_w; const float* gw2; const float* gb; const float* gng;
    const float* wba; const float* wbc; const float* wbg; const float* w_out; const float* ln_mix_g; const float* ln_mix_b;
    const float* router_w; const float* ewg; const float* ewu; const float* ewd; const float* ln_ffn_g; const float* ln_ffn_b;
    float* out; unsigned char* ws; int ph_lo, ph_hi;
};

__device__ __forceinline__ unsigned cvt_pk_bf16(float lo, float hi) { unsigned r; asm("v_cvt_pk_bf16_f32 %0, %1, %2" : "=v"(r) : "v"(lo), "v"(hi)); return r; }
__device__ __forceinline__ float bf_lo(unsigned w) { return __uint_as_float(w << 16); }
__device__ __forceinline__ float bf_hi(unsigned w) { return __uint_as_float(w & 0xffff0000u); }
__device__ __forceinline__ float bf2f(bf16_t b) { return __uint_as_float(((unsigned)b) << 16); }
__device__ __forceinline__ int fresh_tid() { int t = threadIdx.x; asm volatile("" : "+v"(t)); return t; }
__device__ __forceinline__ float wave_sum(float v) {
#pragma unroll
    for (int o = 32; o >= 1; o >>= 1) v += __shfl_xor(v, o);
    return v;
}

constexpr int BM = 256, BK = 64, HALF = 128, HTB = HALF * BK * 2, NXCD = 8, WGM = 8;
__device__ __forceinline__ int lds_byte(int r, int c) { const int st = (r >> 4) * 2 + (c >> 5), rr = r & 15, cc = c & 31, ob = rr * 64 + cc * 2; return st * 1024 + (ob ^ (((ob >> 9) & 1) << 5)); }
__device__ __forceinline__ void stage_rc(int b, int& R, int& C) { const int st = b / 1024, sb = b % 1024, swz = sb ^ (((sb >> 9) & 1) << 5); R = (st >> 1) * 16 + swz / 64; C = (st & 1) * 32 + (swz % 64) / 2; }
__device__ __forceinline__ int perm32(int rho) { const int n = rho >> 4, i = rho & 15; return 8 * (i >> 2) + 4 * n + (i & 3); }

struct Unit { int pm, pn, br; };

struct Sched {
    const char* A; const int* idx; const char* B0; size_t b1off; size_t bstrideE; int bRowsPerPn; int K;
    int nbr; size_t abr, bbr;
    int nM, nN, nwg, G, c;
    __device__ __forceinline__ void init(int nM_, int nN_) { nM = nM_; nN = nN_; nwg = nM * nN; G = gridDim.x; c = blockIdx.x; nbr = 1; abr = 0; bbr = 0; }
    __device__ __forceinline__ bool next(int i0, Unit& u) const {
        const int i = i0 / nbr; u.br = i0 - i * nbr;
        const long L = (long)i * G + c; if (L >= nwg) return false;
        int wgid = (int)L; { const int q = nwg / NXCD, r = nwg % NXCD, xcd = wgid % NXCD, off = wgid / NXCD; wgid = (xcd < r ? xcd * (q + 1) : r * (q + 1) + (xcd - r) * q) + off; }
        const int nig = WGM * nN, gid = wgid / nig, fm = gid * WGM, gsz = (nM - fm) < WGM ? (nM - fm) : WGM;
        u.pm = fm + ((wgid % nig) % gsz); u.pn = (wgid % nig) / gsz; return true;
    }
    __device__ __forceinline__ const char* bptr(const Unit& u) const {
        const size_t eo = bstrideE ? (size_t)(u.pm >> 3) * bstrideE : 0;
        return B0 + eo + (size_t)u.pn * bRowsPerPn * K * 2 + (size_t)u.br * bbr;
    }
};

struct EpiStoreBf16 {
    static constexpr bool PERM = true, MID = false, KEEP = false;
    bf16_t* O; int ldc;
    __device__ __forceinline__ void operator()(const f32x4 (&acc)[2][2][4][2], const Unit& u, int wr, int wc, int fr, int fq) const {
        const int row0 = u.pm * BM + wr * 64 + fr, col0 = u.pn * BM + wc * 32 + 8 * fq;
#pragma unroll
        for (int ai = 0; ai < 2; ++ai)
#pragma unroll
            for (int m = 0; m < 4; ++m) { bf16_t* rowp = O + (size_t)(row0 + ai * HALF + m * 16) * ldc + col0;
#pragma unroll
                for (int bj = 0; bj < 2; ++bj) { const f32x4 v0 = acc[ai][bj][m][0], v1 = acc[ai][bj][m][1];
                    u32x4 w; w.x = cvt_pk_bf16(v0[0], v0[1]); w.y = cvt_pk_bf16(v0[2], v0[3]); w.z = cvt_pk_bf16(v1[0], v1[1]); w.w = cvt_pk_bf16(v1[2], v1[3]);
                    *(u32x4*)(rowp + bj * HALF) = w; } }
    }
};
struct EpiProj {
    static constexpr bool PERM = true, MID = false, KEEP = false;
    bf16_t* O; u32x4* GT;
    __device__ __forceinline__ void operator()(const f32x4 (&acc)[2][2][4][2], const Unit& u, int wr, int wc, int fr, int fq) const {
        if (u.pn < 12) {
            const int tidl = (wr * 4 + wc) * 64 + fq * 16 + fr;
            u32x4* gp = GT + ((size_t)(((u.pn >> 2) * 64 + u.pm) * 4 + (u.pn & 3)) * 16) * 512 + tidl;
#pragma unroll
            for (int ai = 0; ai < 2; ++ai)
#pragma unroll
                for (int m = 0; m < 4; ++m)
#pragma unroll
                    for (int bj = 0; bj < 2; ++bj) { const f32x4 v0 = acc[ai][bj][m][0], v1 = acc[ai][bj][m][1]; float g[8];
#pragma unroll
                        for (int j = 0; j < 4; ++j) { g[j] = __builtin_amdgcn_rcpf(1.0f + __expf(-v0[j])); g[4 + j] = __builtin_amdgcn_rcpf(1.0f + __expf(-v1[j])); }
                        u32x4 w; w.x = cvt_pk_bf16(g[0], g[1]); w.y = cvt_pk_bf16(g[2], g[3]); w.z = cvt_pk_bf16(g[4], g[5]); w.w = cvt_pk_bf16(g[6], g[7]);
                        gp[(size_t)((ai * 4 + m) * 2 + bj) * 512] = w; }
        } else { EpiStoreBf16 st{O, NP}; st(acc, u, wr, wc, fr, fq); }
    }
};
struct EpiMerge {
    static constexpr bool PERM = true, MID = false, KEEP = true;
    const u32x4* GT; bf16_t* O;
    __device__ __forceinline__ void operator()(f32x4 (&acc)[2][2][4][2], const Unit& u, int wr, int wc, int fr, int fq) const {
        const int row0 = u.pm * BM + wr * 64 + fr, col0 = u.pn * BM + wc * 32 + 8 * fq;
        const bool fin = (u.br == 2);
        const int tidl = (wr * 4 + wc) * 64 + fq * 16 + fr;
        const u32x4* gn = GT + ((size_t)((u.br * 64 + u.pm) * 4 + u.pn) * 16) * 512 + tidl;
        const u32x4* gd = gn + (size_t)64 * 4 * 16 * 512;
#pragma unroll
        for (int ai = 0; ai < 2; ++ai)
#pragma unroll
            for (int m = 0; m < 4; ++m) { const size_t row = (size_t)(row0 + ai * HALF + m * 16);
#pragma unroll
                for (int bj = 0; bj < 2; ++bj) { const size_t so = (size_t)((ai * 4 + m) * 2 + bj) * 512;
                    const u32x4 zn = gn[so]; u32x4 zd = zn; if (!fin) zd = gd[so];
                    float f[8];
#pragma unroll
                    for (int q = 0; q < 4; ++q) { f[2 * q] = fin ? bf_lo(zn[q]) : bf_lo(zn[q]) * __builtin_amdgcn_rcpf(bf_lo(zd[q])); f[2 * q + 1] = fin ? bf_hi(zn[q]) : bf_hi(zn[q]) * __builtin_amdgcn_rcpf(bf_hi(zd[q])); }
                    f32x4 v0 = acc[ai][bj][m][0], v1 = acc[ai][bj][m][1];
                    v0[0] *= f[0]; v0[1] *= f[1]; v0[2] *= f[2]; v0[3] *= f[3]; v1[0] *= f[4]; v1[1] *= f[5]; v1[2] *= f[6]; v1[3] *= f[7];
                    acc[ai][bj][m][0] = v0; acc[ai][bj][m][1] = v1;
                    if (fin) { u32x4 w; w.x = cvt_pk_bf16(v0[0], v0[1]); w.y = cvt_pk_bf16(v0[2], v0[3]); w.z = cvt_pk_bf16(v1[0], v1[1]); w.w = cvt_pk_bf16(v1[2], v1[3]);
                        *(u32x4*)(O + row * DM + col0 + bj * HALF) = w; } }
                if (m & 1) { asm volatile("" ::: "memory"); __builtin_amdgcn_sched_barrier(0); } }
    }
};
struct EpiWout {
    static constexpr bool PERM = true, MID = false, KEEP = false;
    const bf16_t* xres; bf16_t* O;
    __device__ __forceinline__ void operator()(const f32x4 (&acc)[2][2][4][2], const Unit& u, int wr, int wc, int fr, int fq) const {
        const int row0 = u.pm * BM + wr * 64 + fr, col0 = u.pn * BM + wc * 32 + 8 * fq;
#pragma unroll
        for (int ai = 0; ai < 2; ++ai) {
            u32x4 xrr[4][2];
#pragma unroll
            for (int m = 0; m < 4; ++m)
#pragma unroll
                for (int bj = 0; bj < 2; ++bj) xrr[m][bj] = *(const u32x4*)(xres + (size_t)(row0 + ai * HALF + m * 16) * DM + col0 + bj * HALF);
#pragma unroll
            for (int m = 0; m < 4; ++m) { const size_t off = (size_t)(row0 + ai * HALF + m * 16) * DM + col0;
#pragma unroll
                for (int bj = 0; bj < 2; ++bj) { const u32x4 xr = xrr[m][bj];
                    const f32x4 v0 = acc[ai][bj][m][0], v1 = acc[ai][bj][m][1];
                    u32x4 w; w.x = cvt_pk_bf16(fmaf(bf_lo(xr.x), ALPHA, v0[0]), fmaf(bf_hi(xr.x), ALPHA, v0[1])); w.y = cvt_pk_bf16(fmaf(bf_lo(xr.y), ALPHA, v0[2]), fmaf(bf_hi(xr.y), ALPHA, v0[3]));
                    w.z = cvt_pk_bf16(fmaf(bf_lo(xr.z), ALPHA, v1[0]), fmaf(bf_hi(xr.z), ALPHA, v1[1])); w.w = cvt_pk_bf16(fmaf(bf_lo(xr.w), ALPHA, v1[2]), fmaf(bf_hi(xr.w), ALPHA, v1[3]));
                    *(u32x4*)(O + off + bj * HALF) = w; } }
            asm volatile("" ::: "memory"); }
    }
};
struct EpiMoe1 {
    static constexpr bool PERM = true, MID = false, KEEP = false;
    bf16_t* O;
    __device__ __forceinline__ void operator()(const f32x4 (&acc)[2][2][4][2], const Unit& u, int wr, int wc, int fr, int fq) const {
        const int row0 = u.pm * BM + wr * 64 + fr, col0 = u.pn * HALF + wc * 32 + 8 * fq;
#pragma unroll
        for (int ai = 0; ai < 2; ++ai)
#pragma unroll
            for (int m = 0; m < 4; ++m) { bf16_t* rowp = O + (size_t)(row0 + ai * HALF + m * 16) * FF + col0;
                float h[8];
#pragma unroll
                for (int n = 0; n < 2; ++n)
#pragma unroll
                    for (int j = 0; j < 4; ++j) { const float g = acc[ai][0][m][n][j], up = acc[ai][1][m][n][j]; h[n * 4 + j] = g * __builtin_amdgcn_rcpf(1.0f + __expf(-g)) * up; }
                u32x4 w; w.x = cvt_pk_bf16(h[0], h[1]); w.y = cvt_pk_bf16(h[2], h[3]); w.z = cvt_pk_bf16(h[4], h[5]); w.w = cvt_pk_bf16(h[6], h[7]);
                *(u32x4*)rowp = w; }
    }
};
struct EpiMoe2 {
    static constexpr bool PERM = true, MID = false, KEEP = false;
    const float* gatev; bf16_t* O;
    __device__ __forceinline__ void operator()(const f32x4 (&acc)[2][2][4][2], const Unit& u, int wr, int wc, int fr, int fq) const {
        const int row0 = u.pm * BM + wr * 64 + fr, col0 = u.pn * BM + wc * 32 + 8 * fq;
        float gvv[2][4];
#pragma unroll
        for (int ai = 0; ai < 2; ++ai)
#pragma unroll
            for (int m = 0; m < 4; ++m) gvv[ai][m] = gatev[row0 + ai * HALF + m * 16];
#pragma unroll
        for (int ai = 0; ai < 2; ++ai)
#pragma unroll
            for (int m = 0; m < 4; ++m) { const int row = row0 + ai * HALF + m * 16; const float gv = gvv[ai][m]; bf16_t* rowp = O + (size_t)row * DM + col0;
#pragma unroll
                for (int bj = 0; bj < 2; ++bj) { const f32x4 v0 = acc[ai][bj][m][0] * gv, v1 = acc[ai][bj][m][1] * gv;
                    u32x4 w; w.x = cvt_pk_bf16(v0[0], v0[1]); w.y = cvt_pk_bf16(v0[2], v0[3]); w.z = cvt_pk_bf16(v1[0], v1[1]); w.w = cvt_pk_bf16(v1[2], v1[3]);
                    *(u32x4*)(rowp + bj * HALF) = w; } }
    }
};

template <bool GATHER, class Epi>
__device__ __forceinline__ void gemm_phase(LAS unsigned char* lds, const Sched& S, const Epi& E) {
    const int tid = fresh_tid(), wid = __builtin_amdgcn_readfirstlane(tid >> 6), lane = tid & 63, wr = wid >> 2, wc = wid & 3, fr = lane & 15, fq = lane >> 4;
    const int K = S.K, nt = K / BK;
    int R0, C0; unsigned voffA[2], voffB[2];
    { int R, C; stage_rc(tid * 16, R, C); R0 = R; C0 = C; }
#pragma unroll
    for (int i = 0; i < 2; ++i) { int R, C; stage_rc(tid * 16 + i * 8192, R, C); const int Rb = Epi::PERM ? ((R & ~31) + perm32(R & 31)) : R; voffA[i] = (unsigned)(R * K + C) * 2u; voffB[i] = (unsigned)(Rb * K + C) * 2u; }
    const size_t kstep = (size_t)(BK * 2);
    const size_t hstep = (size_t)HALF * K * 2;
    const size_t tstep = 2 * hstep;
    const size_t b1off = S.b1off;
    const unsigned ldsw = (unsigned)wid * 1024u;
    const int aoff = lds_byte(wr * 64 + fr, fq * 8), boff = lds_byte(wc * 32 + fr, fq * 8);
#define PG8_SA(b, h) (((b) * 2 + (h)) * HTB)
#define PG8_SB(b, h) ((4 + (b) * 2 + (h)) * HTB)
#define PG8_STAGE(bufoff, gbase, v0, v1) do { unsigned _v0 = (v0), _v1 = (v1); asm volatile("" : "+v"(_v0), "+v"(_v1)); \
        __builtin_amdgcn_global_load_lds((const unsigned*)((const char*)(gbase) + _v0), (LAS unsigned*)(lds + (bufoff) + ldsw), 16, 0, 0); \
        __builtin_amdgcn_global_load_lds((const unsigned*)((const char*)(gbase) + _v1), (LAS unsigned*)(lds + (bufoff) + ldsw + 8192), 16, 0, 0); } while (0)
#define PG8_STAGE_A(bufoff, gbase, h) do { if constexpr (GATHER) PG8_STAGE(bufoff, gbase, go[h][0], go[h][1]); else PG8_STAGE(bufoff, (gbase) + (h) * hstep, voffA[0], voffA[1]); } while (0)
#define PG8_LDA(dst, b, h) do { _Pragma("unroll") for (int m = 0; m < 4; ++m) _Pragma("unroll") for (int k = 0; k < 2; ++k) dst[m][k] = *(const LAS bf16x8*)(lds + PG8_SA(b, h) + aoff + m * 2048 + k * 1024); } while (0)
#define PG8_LDB(dst, b, h) do { _Pragma("unroll") for (int n = 0; n < 2; ++n) _Pragma("unroll") for (int k = 0; k < 2; ++k) dst[n][k] = *(const LAS bf16x8*)(lds + PG8_SB(b, h) + boff + n * 2048 + k * 1024); } while (0)
#define PG8_MMA(ai, bj, At, Bt) do { __builtin_amdgcn_s_setprio(1); _Pragma("unroll") for (int m = 0; m < 4; ++m) _Pragma("unroll") for (int n = 0; n < 2; ++n) _Pragma("unroll") for (int k = 0; k < 2; ++k) \
        acc[ai][bj][m][n] = __builtin_amdgcn_mfma_f32_16x16x32_bf16(Bt[n][k], At[m][k], acc[ai][bj][m][n], 0, 0, 0); __builtin_amdgcn_s_setprio(0); } while (0)
#define PG8_WAIT_V(n) asm volatile("s_waitcnt vmcnt(" #n ")" ::: "memory")
#define PG8_WAIT_L(n) asm volatile("s_waitcnt lgkmcnt(" #n ")" ::: "memory")
#define PG8_BAR __builtin_amdgcn_s_barrier()
#define PG8_SCHED __builtin_amdgcn_sched_barrier(0)
#define PG8_GOFFS(u) do { _Pragma("unroll") for (int h = 0; h < 2; ++h) _Pragma("unroll") for (int i = 0; i < 2; ++i) \
        go[h][i] = (unsigned)(S.idx[(u).pm * BM + h * HALF + R0 + 64 * i] * K + C0) * 2u; } while (0)
#define PG8_TRIP(LAST) do { \
            const char* a1 = cA + (size_t)(t + 1) * kstep; \
            const char* a2 = (LAST) ? nA : cA + (size_t)(t + 2) * kstep; const char* b2 = (LAST) ? nB : cB + (size_t)(t + 2) * kstep; \
            const char* a3 = a2 + kstep; const char* b3 = b2 + kstep; \
            PG8_LDB(B0, 0, 0); PG8_SCHED; PG8_LDA(At, 0, 0); PG8_STAGE_A(PG8_SA(1, 1), a1, 1); \
            PG8_WAIT_L(8); PG8_BAR; PG8_WAIT_L(0); PG8_MMA(0, 0, At, B0); PG8_BAR; PG8_SCHED; \
            if constexpr (GATHER) { if ((LAST) && has_next) PG8_GOFFS(nxt); } \
            PG8_LDB(B1, 0, 1); PG8_STAGE(PG8_SB(0, 0), b2, voffB[0], voffB[1]); \
            PG8_BAR; PG8_WAIT_L(0); PG8_MMA(0, 1, At, B1); PG8_BAR; \
            PG8_LDA(At, 0, 1); PG8_STAGE_A(PG8_SA(0, 0), a2, 0); \
            PG8_BAR; PG8_WAIT_L(0); PG8_MMA(1, 0, At, B0); PG8_BAR; PG8_SCHED; \
            PG8_STAGE(PG8_SB(0, 1), b2 + b1off, voffB[0], voffB[1]); \
            PG8_WAIT_V(6); PG8_BAR; PG8_MMA(1, 1, At, B1); PG8_BAR; \
            PG8_LDB(B0, 1, 0); PG8_SCHED; PG8_LDA(At, 1, 0); PG8_STAGE_A(PG8_SA(0, 1), a2, 1); \
            PG8_WAIT_L(8); PG8_BAR; PG8_WAIT_L(0); PG8_MMA(0, 0, At, B0); PG8_BAR; PG8_SCHED; \
            PG8_LDB(B1, 1, 1); PG8_STAGE(PG8_SB(1, 0), b3, voffB[0], voffB[1]); \
            PG8_BAR; PG8_WAIT_L(0); PG8_MMA(0, 1, At, B1); PG8_BAR; \
            PG8_LDA(At, 1, 1); PG8_STAGE_A(PG8_SA(1, 0), a3, 0); \
            PG8_BAR; PG8_WAIT_L(0); PG8_MMA(1, 0, At, B0); PG8_BAR; PG8_SCHED; \
            PG8_STAGE(PG8_SB(1, 1), b3 + b1off, voffB[0], voffB[1]); \
            PG8_WAIT_V(6); PG8_BAR; PG8_MMA(1, 1, At, B1); PG8_BAR; } while (0)
    Unit cur, nxt; int ui = 0;
    if (!S.next(0, cur)) return;
    f32x4 acc[2][2][4][2];
#pragma unroll
    for (int a = 0; a < 2; ++a)
#pragma unroll
        for (int b = 0; b < 2; ++b)
#pragma unroll
            for (int m = 0; m < 4; ++m)
#pragma unroll
                for (int n = 0; n < 2; ++n) acc[a][b][m][n] = (f32x4){0.f, 0.f, 0.f, 0.f};
    bf16x8 At[4][2], B0[2][2], B1[2][2];
    unsigned go[2][2] = {{0u, 0u}, {0u, 0u}};
    const char* cA = GATHER ? S.A : S.A + (size_t)cur.pm * tstep + (size_t)cur.br * S.abr; const char* cB = S.bptr(cur);
    if constexpr (GATHER) PG8_GOFFS(cur);
    PG8_STAGE(PG8_SB(0, 0), cB, voffB[0], voffB[1]); PG8_STAGE_A(PG8_SA(0, 0), cA, 0); PG8_STAGE(PG8_SB(0, 1), cB + b1off, voffB[0], voffB[1]); PG8_STAGE_A(PG8_SA(0, 1), cA, 1);
    if (wr == 1) PG8_BAR;
    PG8_WAIT_V(4); PG8_BAR;
    PG8_STAGE(PG8_SB(1, 0), cB + kstep, voffB[0], voffB[1]); PG8_STAGE_A(PG8_SA(1, 0), cA + kstep, 0); PG8_STAGE(PG8_SB(1, 1), cB + b1off + kstep, voffB[0], voffB[1]);
    PG8_WAIT_V(6); PG8_BAR;
    for (;;) {
        const bool has_next = S.next(ui + 1, nxt);
        const char* nA = cA; const char* nB = cB;
        if (has_next) { nA = GATHER ? S.A : S.A + (size_t)nxt.pm * tstep + (size_t)nxt.br * S.abr; nB = S.bptr(nxt); }
        int t = 0;
        for (; t < nt - 2; t += 2) PG8_TRIP(false);
        PG8_TRIP(true);
        E(acc, cur, wr, wc, fr, fq);
        PG8_WAIT_V(0);
        if (!has_next) break;
        if (!Epi::KEEP || nxt.br == 0)
#pragma unroll
        for (int a = 0; a < 2; ++a)
#pragma unroll
            for (int b = 0; b < 2; ++b)
#pragma unroll
                for (int m = 0; m < 4; ++m)
#pragma unroll
                    for (int n = 0; n < 2; ++n) acc[a][b][m][n] = (f32x4){0.f, 0.f, 0.f, 0.f};
        cur = nxt; cA = nA; cB = nB; ++ui;
    }
    PG8_WAIT_V(0);
    if (wr == 0) PG8_BAR;
    PG8_BAR;
#undef PG8_SA
#undef PG8_SB
#undef PG8_STAGE
#undef PG8_STAGE_A
#undef PG8_LDA
#undef PG8_LDB
#undef PG8_MMA
#undef PG8_WAIT_V
#undef PG8_WAIT_L
#undef PG8_BAR
#undef PG8_SCHED
#undef PG8_GOFFS
#undef PG8_TRIP
}

__device__ void cvt_job(LAS float* tile, const float* src, bf16_t* dst, int batch, int K, int N, int ldd, int kofs, size_t sbs, size_t dbs, int bid, int nb, int nshift = 0) {
    const int tid = fresh_tid();
    const int tk = K / 64, tn = (N + 63) / 64, per = tk * tn, total = batch * per;
    for (int gi = bid; gi * 4 < total; gi += nb) {
        f32x4 v[4][2];
#pragma unroll
        for (int q = 0; q < 4; ++q) { const int it = gi * 4 + q;
            v[q][0] = (f32x4){0.f, 0.f, 0.f, 0.f}; v[q][1] = (f32x4){0.f, 0.f, 0.f, 0.f};
            if (it < total) { const int b = it / per, r = it % per, k0 = (r / tn) * 64, n0 = (r % tn) * 64;
                const float* sp = src + (size_t)b * sbs + (size_t)k0 * N + n0; const int c4 = (tid & 15) * 4;
                if (n0 + c4 < N) { v[q][0] = *(const f32x4*)(sp + (size_t)(tid >> 4) * N + c4); v[q][1] = *(const f32x4*)(sp + (size_t)((tid >> 4) + 32) * N + c4); } } }
#pragma unroll
        for (int q = 0; q < 4; ++q)
#pragma unroll
            for (int j = 0; j < 2; ++j) { const int row = (tid >> 4) + 32 * j, c4 = (tid & 15) * 4; LAS float* tp = tile + q * (64 * 65) + row * 65 + c4;
                tp[0] = v[q][j][0]; tp[1] = v[q][j][1]; tp[2] = v[q][j][2]; tp[3] = v[q][j][3]; }
        __syncthreads();
#pragma unroll
        for (int q = 0; q < 4; ++q) { const int it = gi * 4 + q;
            if (it < total) { const int b = it / per, r = it % per, k0 = (r / tn) * 64, n0 = (r % tn) * 64;
                const int n = tid >> 3, kc = (tid & 7) * 8;
                if (n0 + n < N) { float f[8];
#pragma unroll
                    for (int j = 0; j < 8; ++j) f[j] = tile[q * (64 * 65) + (kc + j) * 65 + n];
                    u32x4 w; w.x = cvt_pk_bf16(f[0], f[1]); w.y = cvt_pk_bf16(f[2], f[3]); w.z = cvt_pk_bf16(f[4], f[5]); w.w = cvt_pk_bf16(f[6], f[7]);
                    int nd = n0 + n + nshift; if (nd >= N) nd -= N;
                    *(u32x4*)(dst + (size_t)b * dbs + (size_t)nd * ldd + kofs + k0 + kc) = w; } } }
        __syncthreads();
    }
}
__device__ void phase_convert(const Params& p, LAS unsigned char* lds) {
    LAS float* tile = (LAS float*)lds;
    unsigned char* ws = p.ws;
    cvt_job(tile, p.w_in, (bf16_t*)(ws + WS_WIN), NL, 1024, NIN, 1024, 0, (size_t)1024 * NIN, (size_t)NP * 1024, (int)blockIdx.x, (int)gridDim.x, 3072);
    cvt_job(tile, p.wba, (bf16_t*)(ws + WS_WMRG), NL, 512, 1024, 512, 0, (size_t)512 * 1024, (size_t)3 * 1024 * 512, (int)((blockIdx.x + gridDim.x - 104 % gridDim.x) % gridDim.x), (int)gridDim.x);
    cvt_job(tile, p.wbc, (bf16_t*)(ws + WS_WMRG) + (size_t)1024 * 512, NL, 512, 1024, 512, 0, (size_t)512 * 1024, (size_t)3 * 1024 * 512, (int)((blockIdx.x + gridDim.x - 168 % gridDim.x) % gridDim.x), (int)gridDim.x);
    cvt_job(tile, p.wbg, (bf16_t*)(ws + WS_WMRG) + (size_t)2 * 1024 * 512, NL, 512, 1024, 512, 0, (size_t)512 * 1024, (size_t)3 * 1024 * 512, (int)((blockIdx.x + gridDim.x - 232 % gridDim.x) % gridDim.x), (int)gridDim.x);
    cvt_job(tile, p.w_out, (bf16_t*)(ws + WS_WOUT), NL, 1024, 1024, 1024, 0, (size_t)1024 * 1024, (size_t)1024 * 1024, (int)((blockIdx.x + gridDim.x - 40 % gridDim.x) % gridDim.x), (int)gridDim.x);
    cvt_job(tile, p.ewg, (bf16_t*)(ws + WS_WG), NE, 1024, FF, 1024, 0, (size_t)1024 * FF, (size_t)FF * 1024, (int)blockIdx.x, (int)gridDim.x);
    cvt_job(tile, p.ewu, (bf16_t*)(ws + WS_WU), NL * NE, 1024, FF, 1024, 0, (size_t)1024 * FF, (size_t)FF * 1024, (int)blockIdx.x, (int)gridDim.x);
    cvt_job(tile, p.ewd, (bf16_t*)(ws + WS_WD), NE, FF, 1024, FF, 0, (size_t)FF * 1024, (size_t)1024 * FF, (int)blockIdx.x, (int)gridDim.x);
    const f32x4* x4 = (const f32x4*)p.x; u32x2* xb = (u32x2*)(ws + WS_XB);
    { const size_t stride = (size_t)gridDim.x * NTHREADS;
      size_t i = (size_t)blockIdx.x * NTHREADS + fresh_tid();
      for (; i + 3 * stride < (size_t)SEQ * DM / 4; i += 4 * stride) {
        f32x4 v[4];
#pragma unroll
        for (int q = 0; q < 4; ++q) v[q] = x4[i + q * stride];
#pragma unroll
        for (int q = 0; q < 4; ++q) { u32x2 w; w.x = cvt_pk_bf16(v[q][0], v[q][1]); w.y = cvt_pk_bf16(v[q][2], v[q][3]); xb[i + q * stride] = w; } }
      for (; i < (size_t)SEQ * DM / 4; i += stride) { const f32x4 v = x4[i]; u32x2 w; w.x = cvt_pk_bf16(v[0], v[1]); w.y = cvt_pk_bf16(v[2], v[3]); xb[i] = w; } }
}

__device__ void attn_naive(const Params& p, int l, const bf16_t* proj, bf16_t* ycat) {
    for (int g = blockIdx.x * NTHREADS + fresh_tid(); g < 8 * SEQ; g += gridDim.x * NTHREADS) {
        const int hq = g >> 14, t = g & (SEQ - 1), hk = hq >> 2;
        float q[64], acc[64];
        { const u32x4* qp = (const u32x4*)(proj + (size_t)t * NP + AQ + hq * 64);
#pragma unroll
          for (int c = 0; c < 8; ++c) { const u32x4 w = qp[c];
#pragma unroll
              for (int e = 0; e < 4; ++e) { q[c * 8 + e * 2] = bf_lo(w[e]) * 0.125f; q[c * 8 + e * 2 + 1] = bf_hi(w[e]) * 0.125f; } } }
#pragma unroll
        for (int d = 0; d < 64; ++d) acc[d] = 0.f;
        const float slope = exp2f(-(float)(hq + 1)); const float sink = p.attn_sink[l * 8 + hq];
        float mx = sink, den = 1.0f;
        const int lo = t - 128 < 0 ? 0 : t - 128, hi = t + 128 > SEQ - 1 ? SEQ - 1 : t + 128;
        for (int s = lo; s <= hi; ++s) {
            const u32x4* kp = (const u32x4*)(proj + (size_t)s * NP + AK + hk * 64);
            float sc = 0.f;
#pragma unroll
            for (int c = 0; c < 8; ++c) { const u32x4 w = kp[c];
#pragma unroll
                for (int e = 0; e < 4; ++e) { sc += q[c * 8 + e * 2] * bf_lo(w[e]); sc += q[c * 8 + e * 2 + 1] * bf_hi(w[e]); } }
            const int dist = t > s ? t - s : s - t;
            sc -= slope * (float)dist;
            if (sc > mx) { const float f = __expf(mx - sc); den *= f;
#pragma unroll
                for (int d = 0; d < 64; ++d) acc[d] *= f;
                mx = sc; }
            const float pr = __expf(sc - mx); den += pr;
            const u32x4* vp = (const u32x4*)(proj + (size_t)s * NP + AV + hk * 64);
#pragma unroll
            for (int c = 0; c < 8; ++c) { const u32x4 w = vp[c];
#pragma unroll
                for (int e = 0; e < 4; ++e) { acc[c * 8 + e * 2] += pr * bf_lo(w[e]); acc[c * 8 + e * 2 + 1] += pr * bf_hi(w[e]); } }
        }
        const float inv = 1.0f / den;
        u32x4* op = (u32x4*)(ycat + (size_t)t * 512 + hq * 64);
#pragma unroll
        for (int c = 0; c < 8; ++c) { u32x4 w; w.x = cvt_pk_bf16(acc[c * 8] * inv, acc[c * 8 + 1] * inv); w.y = cvt_pk_bf16(acc[c * 8 + 2] * inv, acc[c * 8 + 3] * inv);
            w.z = cvt_pk_bf16(acc[c * 8 + 4] * inv, acc[c * 8 + 5] * inv); w.w = cvt_pk_bf16(acc[c * 8 + 6] * inv, acc[c * 8 + 7] * inv); op[c] = w; }
    }
}
__device__ void attn_mfma(const Params& p, int l, const bf16_t* proj, bf16_t* y0, LAS unsigned char* lds) {
    constexpr int KP = 72, VP = 392;
    LAS bf16_t* Ks = (LAS bf16_t*)lds;
    LAS bf16_t* Vt = (LAS bf16_t*)(lds + 384 * KP * 2);
    const int tid = fresh_tid(), lane = tid & 63, wv = tid >> 6, fr = lane & 15, g = lane >> 4;
    for (int it = blockIdx.x; it < 256; it += gridDim.x) {
        const int n = it >> 1, hk = it & 1, kbase = (n - 1) * 128;
        __syncthreads();
        {
            u32x4 kreg[6], va[3], vb[3];
#pragma unroll
            for (int q = 0; q < 6; ++q) { const int c = tid + q * NTHREADS, row = c >> 3, part = c & 7, s = kbase + row;
                kreg[q] = (u32x4){0u, 0u, 0u, 0u}; if (s >= 0 && s < SEQ) kreg[q] = *(const u32x4*)(proj + (size_t)s * NP + AK + hk * 64 + part * 8); }
#pragma unroll
            for (int q = 0; q < 3; ++q) { const int c = tid + q * NTHREADS, pr = c >> 3, part = c & 7, s = kbase + pr * 2;
                va[q] = (u32x4){0u, 0u, 0u, 0u}; vb[q] = (u32x4){0u, 0u, 0u, 0u};
                if (s >= 0 && s < SEQ) { va[q] = *(const u32x4*)(proj + (size_t)s * NP + AV + hk * 64 + part * 8); vb[q] = *(const u32x4*)(proj + (size_t)(s + 1) * NP + AV + hk * 64 + part * 8); } }
#pragma unroll
            for (int q = 0; q < 6; ++q) { const int c = tid + q * NTHREADS, row = c >> 3, part = c & 7; *(LAS u32x4*)(Ks + row * KP + part * 8) = kreg[q]; }
#pragma unroll
            for (int q = 0; q < 3; ++q) { const int c = tid + q * NTHREADS, pr = c >> 3, part = c & 7; const u32x4 a = va[q], b = vb[q];
#pragma unroll
                for (int e = 0; e < 4; ++e) {
                    *(LAS unsigned*)(Vt + (part * 8 + 2 * e) * VP + pr * 2) = (a[e] & 0xffffu) | (b[e] << 16);
                    *(LAS unsigned*)(Vt + (part * 8 + 2 * e + 1) * VP + pr * 2) = (a[e] >> 16) | (b[e] & 0xffff0000u); } }
        }
        const int hq = hk * 4 + (wv >> 1);
        bf16x8 qn[2];
#pragma unroll
        for (int ks = 0; ks < 2; ++ks) qn[ks] = *(const bf16x8*)(proj + (size_t)(n * 128 + (wv & 1) * 64 + fr) * NP + AQ + hq * 64 + ks * 32 + g * 8);
        __syncthreads();
        const float slope = exp2f(-(float)(hq + 1)), sink = p.attn_sink[l * 8 + hq];
        const bool edge = (n == 0) || (n == SEQ / 128 - 1);
        for (int tile = 0; tile < 4; ++tile) {
            const int tl = (wv & 1) * 64 + tile * 16 + fr, t = n * 128 + tl;
            bf16x8 qf[2];
#pragma unroll
            for (int ks = 0; ks < 2; ++ks) { qf[ks] = qn[ks]; qn[ks] = *(const bf16x8*)(proj + (size_t)(t + (tile < 3 ? 16 : 0)) * NP + AQ + hq * 64 + ks * 32 + g * 8); }
            f32x4 sacc[24];
#pragma unroll
            for (int kt = 0; kt < 24; ++kt) { f32x4 a = {0.f, 0.f, 0.f, 0.f};
#pragma unroll
                for (int ks = 0; ks < 2; ++ks) { const bf16x8 kf = *(const LAS bf16x8*)(Ks + (kt * 16 + fr) * KP + ks * 32 + g * 8); a = __builtin_amdgcn_mfma_f32_16x16x32_bf16(kf, qf[ks], a, 0, 0, 0); }
                sacc[kt] = a; if ((kt & 7) == 7) __builtin_amdgcn_sched_barrier(0); }
            const float tq = (float)(tl + 128 - 4 * g);
            float mx = sink;
#pragma unroll
            for (int kt = 0; kt < 24; ++kt)
#pragma unroll
                for (int r = 0; r < 4; ++r) { const float x = (float)(kt * 16 + r) - tq; float sc = fmaf(sacc[kt][r], 0.125f, -slope * fabsf(x));
                    bool valid = fabsf(x) <= 128.0f;
                    if (edge) { const int kl = kt * 16 + 4 * g + r; valid = valid && (n == 0 ? kl >= 128 : kl < 256); }
                    sc = valid ? sc : -1e30f; sacc[kt][r] = sc; mx = fmaxf(mx, sc); }
            mx = fmaxf(mx, __shfl_xor(mx, 16)); mx = fmaxf(mx, __shfl_xor(mx, 32));
            float sum = 0.f; const float mxl = mx * 1.44269504f;
#pragma unroll
            for (int kt = 0; kt < 24; ++kt)
#pragma unroll
                for (int r = 0; r < 4; ++r) { const float pr = exp2f(fmaf(sacc[kt][r], 1.44269504f, -mxl)); sacc[kt][r] = pr; sum += pr; }
            sum += __shfl_xor(sum, 16); sum += __shfl_xor(sum, 32);
            const float inv = 1.0f / (sum + __expf(sink - mx));
            f32x4 oacc[4];
#pragma unroll
            for (int dt = 0; dt < 4; ++dt) oacc[dt] = (f32x4){0.f, 0.f, 0.f, 0.f};
#pragma unroll
            for (int i = 0; i < 12; ++i) {
                u32x4 pw; pw.x = cvt_pk_bf16(sacc[2 * i][0], sacc[2 * i][1]); pw.y = cvt_pk_bf16(sacc[2 * i][2], sacc[2 * i][3]); pw.z = cvt_pk_bf16(sacc[2 * i + 1][0], sacc[2 * i + 1][1]); pw.w = cvt_pk_bf16(sacc[2 * i + 1][2], sacc[2 * i + 1][3]);
                const bf16x8 pf = __builtin_bit_cast(bf16x8, pw);
#pragma unroll
                for (int dt = 0; dt < 4; ++dt) { const LAS bf16_t* vp = Vt + (dt * 16 + fr) * VP + 32 * i + 4 * g;
                    const u32x2 lo = *(const LAS u32x2*)vp, hi = *(const LAS u32x2*)(vp + 16);
                    u32x4 vw; vw.x = lo.x; vw.y = lo.y; vw.z = hi.x; vw.w = hi.y;
                    oacc[dt] = __builtin_amdgcn_mfma_f32_16x16x32_bf16(__builtin_bit_cast(bf16x8, vw), pf, oacc[dt], 0, 0, 0); }
                if ((i % 3) == 2) __builtin_amdgcn_sched_barrier(0); }
#pragma unroll
            for (int dt = 0; dt < 4; ++dt) { u32x2 w; w.x = cvt_pk_bf16(oacc[dt][0] * inv, oacc[dt][1] * inv); w.y = cvt_pk_bf16(oacc[dt][2] * inv, oacc[dt][3] * inv);
                *(u32x2*)(y0 + (size_t)t * 512 + hq * 64 + dt * 16 + 4 * g) = w; }
        }
    }
}
__device__ void conv_naive(const Params& p, int l, const bf16_t* proj, bf16_t* ycat) {
    for (int gidx = blockIdx.x * NTHREADS + fresh_tid(); gidx < (SEQ / 8) * 128; gidx += gridDim.x * NTHREADS) {
        const int tb = (gidx >> 7) * 8, c = (gidx & 127) * 4;
        u32x2 hh[10], cc[10], bb[8];
#pragma unroll
        for (int j = 0; j < 10; ++j) { const int ts = tb + j - 1; const bool ok = ts >= 0 && ts < SEQ; const int tc = ok ? ts : tb;
            hh[j] = *(const u32x2*)(proj + (size_t)tc * NP + CH + c); cc[j] = *(const u32x2*)(proj + (size_t)tc * NP + CC + c);
            if (!ok) { hh[j].x = 0u; hh[j].y = 0u; } }
#pragma unroll
        for (int j = 0; j < 8; ++j) bb[j] = *(const u32x2*)(proj + (size_t)(tb + j) * NP + CB + c);
        f32x4 w[3];
#pragma unroll
        for (int j = 0; j < 3; ++j) w[j] = *(const f32x4*)(p.conv_w + ((size_t)l * 3 + j) * 512 + c);
        f32x4 u[10];
#pragma unroll
        for (int j = 0; j < 10; ++j) { u[j][0] = bf_lo(hh[j].x) * bf_lo(cc[j].x); u[j][1] = bf_hi(hh[j].x) * bf_hi(cc[j].x); u[j][2] = bf_lo(hh[j].y) * bf_lo(cc[j].y); u[j][3] = bf_hi(hh[j].y) * bf_hi(cc[j].y); }
#pragma unroll
        for (int j = 0; j < 8; ++j) { const f32x4 a = w[0] * u[j] + w[1] * u[j + 1] + w[2] * u[j + 2];
            u32x2 o; o.x = cvt_pk_bf16(a[0] * bf_lo(bb[j].x), a[1] * bf_hi(bb[j].x)); o.y = cvt_pk_bf16(a[2] * bf_lo(bb[j].y), a[3] * bf_hi(bb[j].y));
            *(u32x2*)(ycat + (size_t)SEQ * 512 + (size_t)(tb + j) * 512 + c) = o; }
    }
}
constexpr int GP = 72;
constexpr int G_QT = 0, G_KT = 9216, G_KH = 18432, G_VT = 27648, G_PP = 46080, G_EBL = 55296, G_PART = 55552;
template <bool OUT>
__device__ __forceinline__ void gla_chunks(const Params& p, int l, const bf16_t* proj, LAS unsigned char* lds, int seg, int h, int dir, f32x4 (&Sacc)[4], float* outbuf, float& alog) {
    LAS bf16_t* QT = (LAS bf16_t*)(lds + G_QT); LAS bf16_t* KT = (LAS bf16_t*)(lds + G_KT); LAS bf16_t* KH = (LAS bf16_t*)(lds + G_KH);
    LAS bf16_t* VT = (LAS bf16_t*)(lds + G_VT); LAS bf16_t* PP = (LAS bf16_t*)(lds + G_PP); LAS float* EBL = (LAS float*)(lds + G_EBL); LAS float* PART = (LAS float*)(lds + G_PART);
    const int tid = fresh_tid(), lane = tid & 63, wv = __builtin_amdgcn_readfirstlane(tid >> 6), fr = lane & 15, g = lane >> 4;
    const int d = lane, tb = wv;
    const float* w2 = p.gw2 + ((size_t)(l * 2 + dir) * 16) * 256 + h * 64 + d; const float bias = p.gb[(l * 2 + dir) * 256 + h * 64 + d];
    float w[16];
#pragma unroll
    for (int r = 0; r < 16; ++r) w[r] = w2[r * 256];
    for (int c = 0; c < 4; ++c) {
        const int t0 = seg * SEGLEN + (dir ? 3 - c : c) * 64;
        float bq[8], qv[8], kv[8];
        { u32x4 L0[8], L1[8]; bf16_t kr[8], qr[8];
#pragma unroll
          for (int j = 0; j < 8; ++j) { const int i = tb * 8 + j, t = dir ? t0 + 63 - i : t0 + i;
              const u32x4* lr = (const u32x4*)(proj + (size_t)t * NP + GLR + dir * 16); L0[j] = lr[0]; L1[j] = lr[1];
              kr[j] = proj[(size_t)t * NP + GK + h * 64 + d]; qr[j] = OUT ? proj[(size_t)t * NP + GQ + h * 64 + d] : (bf16_t)0; }
          __builtin_amdgcn_sched_barrier(0);
          float run = 0.f;
#pragma unroll
          for (int j = 0; j < 8; ++j) { const u32x4 l0 = L0[j], l1 = L1[j]; float z = bias;
#pragma unroll
              for (int e = 0; e < 4; ++e) { z += bf_lo(l0[e]) * w[e * 2] + bf_hi(l0[e]) * w[e * 2 + 1]; z += bf_lo(l1[e]) * w[8 + e * 2] + bf_hi(l1[e]) * w[8 + e * 2 + 1]; }
              const float ls = fminf(z, 0.f) - __logf(1.0f + __expf(-fabsf(z)));
              run += ls * (1.0f / 16.0f); bq[j] = run;
              kv[j] = bf2f(kr[j]);
              if (OUT) qv[j] = bf2f(qr[j]) * 0.125f; }
          PART[tb * 64 + d] = run; }
        { const int pr = tid >> 4, part = tid & 15; const int i0 = 2 * pr, ta = dir ? t0 + 63 - i0 : t0 + i0, tbb = dir ? ta - 1 : ta + 1;
          const u32x4 a = *(const u32x4*)(proj + (size_t)ta * NP + GV + h * 128 + part * 8), b = *(const u32x4*)(proj + (size_t)tbb * NP + GV + h * 128 + part * 8);
#pragma unroll
          for (int e = 0; e < 4; ++e) {
              *(LAS unsigned*)(VT + (part * 8 + 2 * e) * GP + i0) = (a[e] & 0xffffu) | (b[e] << 16);
              *(LAS unsigned*)(VT + (part * 8 + 2 * e + 1) * GP + i0) = (a[e] >> 16) | (b[e] & 0xffff0000u); } }
        __syncthreads();
        { float off = 0.f, tot = 0.f;
#pragma unroll
          for (int q = 0; q < 8; ++q) { const float v = PART[q * 64 + d]; tot += v; if (q < tb) off += v; }
          if (tb == 0) { EBL[d] = __expf(tot); alog += tot; }
          unsigned kh[4];
#pragma unroll
          for (int j = 0; j < 8; j += 2) { const float b0 = bq[j] + off, b1 = bq[j + 1] + off;
              const int i = tb * 8 + j;
              if (OUT) { QT[i * GP + d] = (bf16_t)(cvt_pk_bf16(qv[j] * __expf(b0), 0.f) & 0xffffu); QT[(i + 1) * GP + d] = (bf16_t)(cvt_pk_bf16(qv[j + 1] * __expf(b1), 0.f) & 0xffffu);
                         KT[i * GP + d] = (bf16_t)(cvt_pk_bf16(kv[j] * __expf(-b0), 0.f) & 0xffffu); KT[(i + 1) * GP + d] = (bf16_t)(cvt_pk_bf16(kv[j + 1] * __expf(-b1), 0.f) & 0xffffu); }
              kh[j >> 1] = cvt_pk_bf16(kv[j] * __expf(tot - b0), kv[j + 1] * __expf(tot - b1)); }
          u32x4 kw; kw.x = kh[0]; kw.y = kh[1]; kw.z = kh[2]; kw.w = kh[3];
          *(LAS u32x4*)(KH + d * GP + tb * 8) = kw; }
        __syncthreads();
        if (OUT) {
#pragma unroll
            for (int q = 0; q < 2; ++q) { const int tt = 2 * wv + q, jt = tt >> 2, it = tt & 3;
                f32x4 a = {0.f, 0.f, 0.f, 0.f};
                if (it >= jt) {
#pragma unroll
                    for (int ks = 0; ks < 2; ++ks) { const bf16x8 kf = *(const LAS bf16x8*)(KT + (jt * 16 + fr) * GP + ks * 32 + g * 8), qf = *(const LAS bf16x8*)(QT + (it * 16 + fr) * GP + ks * 32 + g * 8);
                        a = __builtin_amdgcn_mfma_f32_16x16x32_bf16(kf, qf, a, 0, 0, 0); }
                    const int i = it * 16 + fr, j0 = jt * 16 + 4 * g;
#pragma unroll
                    for (int r = 0; r < 4; ++r) if (j0 + r > i) a[r] = 0.f; }
                u32x2 pw; pw.x = cvt_pk_bf16(a[0], a[1]); pw.y = cvt_pk_bf16(a[2], a[3]);
                *(LAS u32x2*)(PP + (it * 16 + fr) * GP + jt * 16 + 4 * g) = pw; }
            __syncthreads();
        }
        bf16x8 bv[2];
#pragma unroll
        for (int ks = 0; ks < 2; ++ks) bv[ks] = *(const LAS bf16x8*)(VT + (16 * wv + fr) * GP + 32 * ks + 8 * g);
        if (OUT) {
            bf16x8 bs[2];
#pragma unroll
            for (int m = 0; m < 2; ++m) { u32x4 sw; sw.x = cvt_pk_bf16(Sacc[2 * m][0], Sacc[2 * m][1]); sw.y = cvt_pk_bf16(Sacc[2 * m][2], Sacc[2 * m][3]); sw.z = cvt_pk_bf16(Sacc[2 * m + 1][0], Sacc[2 * m + 1][1]); sw.w = cvt_pk_bf16(Sacc[2 * m + 1][2], Sacc[2 * m + 1][3]); bs[m] = __builtin_bit_cast(bf16x8, sw); }
#pragma unroll
            for (int it = 0; it < 4; ++it) { f32x4 o = {0.f, 0.f, 0.f, 0.f};
#pragma unroll
                for (int ks = 0; ks < 2; ++ks) { const bf16x8 pf = *(const LAS bf16x8*)(PP + (it * 16 + fr) * GP + 32 * ks + 8 * g); o = __builtin_amdgcn_mfma_f32_16x16x32_bf16(pf, bv[ks], o, 0, 0, 0); }
#pragma unroll
                for (int m = 0; m < 2; ++m) { const LAS bf16_t* qp = QT + (it * 16 + fr) * GP + 32 * m + 4 * g; const u32x2 lo = *(const LAS u32x2*)qp, hi = *(const LAS u32x2*)(qp + 16);
                    u32x4 qw; qw.x = lo.x; qw.y = lo.y; qw.z = hi.x; qw.w = hi.y; o = __builtin_amdgcn_mfma_f32_16x16x32_bf16(__builtin_bit_cast(bf16x8, qw), bs[m], o, 0, 0, 0); }
#pragma unroll
                for (int r = 0; r < 4; ++r) { const int i = it * 16 + 4 * g + r, t = dir ? t0 + 63 - i : t0 + i; outbuf[(size_t)t * 512 + h * 128 + 16 * wv + fr] = o[r]; } }
        }
#pragma unroll
        for (int dt = 0; dt < 4; ++dt) { const f32x4 eb = *(const LAS f32x4*)(EBL + dt * 16 + 4 * g); f32x4 a = Sacc[dt] * eb;
#pragma unroll
            for (int ks = 0; ks < 2; ++ks) { const bf16x8 kf = *(const LAS bf16x8*)(KH + (dt * 16 + fr) * GP + 32 * ks + 8 * g); a = __builtin_amdgcn_mfma_f32_16x16x32_bf16(kf, bv[ks], a, 0, 0, 0); }
            Sacc[dt] = a; }
        __syncthreads();
    }
}
__device__ void gla_pass1(const Params& p, int l, const bf16_t* proj, LAS unsigned char* lds) {
    float* GE = (float*)(p.ws + WS_GE); float* GA = (float*)(p.ws + WS_GASEG);
    for (int it = blockIdx.x; it < NSEG * 8; it += gridDim.x) {
        const int seg = it >> 3, h = (it >> 1) & 3, dir = it & 1;
        const int tid = fresh_tid(), lane = tid & 63, wv = tid >> 6, fr = lane & 15, g = lane >> 4;
        f32x4 Sacc[4];
#pragma unroll
        for (int dt = 0; dt < 4; ++dt) Sacc[dt] = (f32x4){0.f, 0.f, 0.f, 0.f};
        float alog = 0.f;
        gla_chunks<false>(p, l, proj, lds, seg, h, dir, Sacc, nullptr, alog);
        const size_t base = (size_t)(seg * 2 + dir) * 32768 + (size_t)h * 8192;
#pragma unroll
        for (int dt = 0; dt < 4; ++dt)
#pragma unroll
            for (int r = 0; r < 4; ++r) GE[base + (size_t)(dt * 16 + 4 * g + r) * 128 + 16 * wv + fr] = Sacc[dt][r];
        if (tid < 64) GA[((seg * 2 + dir) * 4 + h) * 64 + tid] = __expf(alog);
    }
}
__device__ void gla_scan(const Params& p) {
    const float* GE = (const float*)(p.ws + WS_GE); const float* GA = (const float*)(p.ws + WS_GASEG); float* GS = (float*)(p.ws + WS_GSIN);
    for (int g = blockIdx.x * NTHREADS + fresh_tid(); g < 65536; g += gridDim.x * NTHREADS) {
        const int dir = g >> 15, r = g & 32767, h = r >> 13, d = (r >> 7) & 63;
        float S = 0.f;
        for (int i0 = 0; i0 < NSEG; i0 += 8) { float ea[8], aa[8];
#pragma unroll
            for (int q = 0; q < 8; ++q) { const int seg = dir ? NSEG - 1 - (i0 + q) : i0 + q; ea[q] = GE[(size_t)(seg * 2 + dir) * 32768 + r]; aa[q] = GA[((seg * 2 + dir) * 4 + h) * 64 + d]; }
#pragma unroll
            for (int q = 0; q < 8; ++q) { const int seg = dir ? NSEG - 1 - (i0 + q) : i0 + q; GS[(size_t)(seg * 2 + dir) * 32768 + r] = S; S = aa[q] * S + ea[q]; } }
    }
}
__device__ void gla_pass2(const Params& p, int l, const bf16_t* proj, bf16_t* ycat, LAS unsigned char* lds) {
    const float* GS = (const float*)(p.ws + WS_GSIN); float* OF = (float*)(p.ws + WS_OF); float* OB = (float*)(p.ws + WS_OF2);
    for (int it = blockIdx.x; it < NSEG * 4; it += gridDim.x) {
        const int seg = it >> 2, h = it & 3;
        const int tid = fresh_tid(), lane = tid & 63, wv = tid >> 6, fr = lane & 15, g = lane >> 4;
        for (int dir = 0; dir < 2; ++dir) {
            f32x4 Sacc[4];
            const size_t base = (size_t)(seg * 2 + dir) * 32768 + (size_t)h * 8192;
#pragma unroll
            for (int dt = 0; dt < 4; ++dt)
#pragma unroll
                for (int r = 0; r < 4; ++r) Sacc[dt][r] = GS[base + (size_t)(dt * 16 + 4 * g + r) * 128 + 16 * wv + fr];
            float alog = 0.f;
            gla_chunks<true>(p, l, proj, lds, seg, h, dir, Sacc, dir ? OB : OF, alog);
        }
        __syncthreads();
        const f32x2 gg = *(const f32x2*)(p.gng + l * 512 + h * 128 + lane * 2);
        for (int j0 = 0; j0 < 32; j0 += 8) {
            f32x2 of[8], ob[8]; unsigned rw[8];
#pragma unroll
            for (int j = 0; j < 8; ++j) { const int t = seg * SEGLEN + wv * 32 + j0 + j; const size_t oo = (size_t)t * 512 + h * 128 + lane * 2;
                of[j] = *(const f32x2*)(OF + oo); ob[j] = *(const f32x2*)(OB + oo); rw[j] = *(const unsigned*)(proj + (size_t)t * NP + GR + h * 128 + lane * 2); }
#pragma unroll
            for (int j = 0; j < 8; ++j) { const int t = seg * SEGLEN + wv * 32 + j0 + j;
                const float o0 = of[j][0] + ob[j][0], o1 = of[j][1] + ob[j][1];
                const float ss = wave_sum(o0 * o0 + o1 * o1);
                const float rs = rsqrtf(ss * (1.0f / 128.0f) + 1e-6f);
                const float r0 = bf_lo(rw[j]), r1 = bf_hi(rw[j]);
                const float y0 = o0 * rs * gg[0] * (r0 / (1.0f + __expf(-r0))), y1 = o1 * rs * gg[1] * (r1 / (1.0f + __expf(-r1)));
                *(unsigned*)(ycat + (size_t)2 * SEQ * 512 + (size_t)t * 512 + h * 128 + lane * 2) = cvt_pk_bf16(y0, y1); } }
        __syncthreads();
    }
}

constexpr int RWP = 1028;
__device__ void phase_ln1_router(const Params& p, int l, LAS unsigned char* lds) {
    LAS float* rw_s = (LAS float*)lds;
    const int tid = fresh_tid(), lane = tid & 63, wv = tid >> 6;
    const float* rw = p.router_w + (size_t)l * DM * NE;
    for (int i0 = 0; i0 < DM * NE; i0 += 8 * NTHREADS) { float rr[8];
#pragma unroll
        for (int q = 0; q < 8; ++q) rr[q] = rw[i0 + q * NTHREADS + tid];
#pragma unroll
        for (int q = 0; q < 8; ++q) { const int i = i0 + q * NTHREADS + tid, d = i >> 4, e = i & 15; rw_s[e * RWP + d] = rr[q]; } }
    __syncthreads();
    const bf16_t* XP = (const bf16_t*)(p.ws + WS_XA); bf16_t* XB = (bf16_t*)(p.ws + WS_XB); float* AFF = (float*)(p.ws + WS_AFF);
    const float* g = p.ln_mix_g + l * DM; const float* b = p.ln_mix_b + l * DM;
    f32x4 gv[4], bv[4];
#pragma unroll
    for (int j = 0; j < 4; ++j) { gv[j] = *(const f32x4*)(g + lane * 4 + 256 * j); bv[j] = *(const f32x4*)(b + lane * 4 + 256 * j); }
    const int rstride = gridDim.x * 8;
    u32x2 raw[4];
    { const int row0 = blockIdx.x * 8 + wv;
      if (row0 < SEQ) {
#pragma unroll
          for (int j = 0; j < 4; ++j) raw[j] = *(const u32x2*)(XP + (size_t)row0 * DM + lane * 4 + 256 * j); } }
    for (int row = blockIdx.x * 8 + wv; row < SEQ; row += rstride) {
        f32x4 v[4]; float s = 0.f;
#pragma unroll
        for (int j = 0; j < 4; ++j) { const u32x2 w = raw[j]; v[j] = (f32x4){bf_lo(w.x), bf_hi(w.x), bf_lo(w.y), bf_hi(w.y)}; s += (v[j][0] + v[j][1]) + (v[j][2] + v[j][3]); }
        if (row + rstride < SEQ) {
#pragma unroll
            for (int j = 0; j < 4; ++j) raw[j] = *(const u32x2*)(XP + (size_t)(row + rstride) * DM + lane * 4 + 256 * j); }
        const float mean = wave_sum(s) * (1.0f / 1024.0f); float q = 0.f;
#pragma unroll
        for (int j = 0; j < 4; ++j) { v[j] = v[j] - mean; q += (v[j][0] * v[j][0] + v[j][1] * v[j][1]) + (v[j][2] * v[j][2] + v[j][3] * v[j][3]); }
        const float rstd = rsqrtf(wave_sum(q) * (1.0f / 1024.0f) + 1e-5f);
#pragma unroll
        for (int j = 0; j < 4; ++j) { v[j] = v[j] * rstd * gv[j] + bv[j];
            u32x2 w; w.x = cvt_pk_bf16(v[j][0], v[j][1]); w.y = cvt_pk_bf16(v[j][2], v[j][3]); *(u32x2*)(XB + (size_t)row * DM + lane * 4 + 256 * j) = w; }
        float a16[16];
#pragma unroll
        for (int e = 0; e < 16; ++e) { float a = 0.f;
#pragma unroll
            for (int j = 0; j < 4; ++j) { const f32x4 w = *(const LAS f32x4*)(rw_s + e * RWP + lane * 4 + 256 * j); a += v[j][0] * w[0] + v[j][1] * w[1] + v[j][2] * w[2] + v[j][3] * w[3]; }
            a16[e] = a; }
        float b8[8], c4[4], d2[2];
        { const bool hi = (lane & 32) != 0;
#pragma unroll
          for (int i = 0; i < 8; ++i) { const float keep = hi ? a16[8 + i] : a16[i], send = hi ? a16[i] : a16[8 + i]; b8[i] = keep + __shfl_xor(send, 32); } }
        { const bool hi = (lane & 16) != 0;
#pragma unroll
          for (int i = 0; i < 4; ++i) { const float keep = hi ? b8[4 + i] : b8[i], send = hi ? b8[i] : b8[4 + i]; c4[i] = keep + __shfl_xor(send, 16); } }
        { const bool hi = (lane & 8) != 0;
#pragma unroll
          for (int i = 0; i < 2; ++i) { const float keep = hi ? c4[2 + i] : c4[i], send = hi ? c4[i] : c4[2 + i]; d2[i] = keep + __shfl_xor(send, 8); } }
        float lgt; { const bool hi = (lane & 4) != 0; const float keep = hi ? d2[1] : d2[0], send = hi ? d2[0] : d2[1]; lgt = keep + __shfl_xor(send, 4); }
        lgt += __shfl_xor(lgt, 2); lgt += __shfl_xor(lgt, 1);
        float mx = lgt;
        mx = fmaxf(mx, __shfl_xor(mx, 4)); mx = fmaxf(mx, __shfl_xor(mx, 8)); mx = fmaxf(mx, __shfl_xor(mx, 16)); mx = fmaxf(mx, __shfl_xor(mx, 32));
        const float ex = expf(lgt - mx);
        float den = ex; den += __shfl_xor(den, 4); den += __shfl_xor(den, 8); den += __shfl_xor(den, 16); den += __shfl_xor(den, 32);
        const int eidx = ((lane >> 5) & 1) * 8 + ((lane >> 4) & 1) * 4 + ((lane >> 3) & 1) * 2 + ((lane >> 2) & 1);
        if ((lane & 3) == 0) AFF[(size_t)eidx * SEQ + row] = ex / den;
    }
}
__device__ void phase_topk(const Params& p, int l, LAS unsigned char* lds) {
    if (blockIdx.x >= NE) {
        if (l == 1 && gridDim.x > NE) cvt_job((LAS float*)lds, p.ewg + (size_t)NE * FF * 1024, (bf16_t*)(p.ws + WS_WG) + (size_t)NE * FF * 1024, NE, 1024, FF, 1024, 0, (size_t)1024 * FF, (size_t)FF * 1024, (int)blockIdx.x - NE, (int)gridDim.x - NE);
        if (l == 0 && gridDim.x > NE) cvt_job((LAS float*)lds, p.ewd + (size_t)NE * FF * 1024, (bf16_t*)(p.ws + WS_WD) + (size_t)NE * FF * 1024, NE, FF, 1024, FF, 0, (size_t)FF * 1024, (size_t)1024 * FF, (int)blockIdx.x - NE, (int)gridDim.x - NE);
        return; }
    const int e = blockIdx.x, tid = fresh_tid(), lane = tid & 63;
    LAS unsigned* keys = (LAS unsigned*)lds;
    LAS unsigned* hist = keys + SEQ;
    LAS unsigned* ctl = hist + 256;
    const unsigned* aff = (const unsigned*)(p.ws + WS_AFF) + (size_t)e * SEQ;
    int* IDX = (int*)(p.ws + WS_IDX) + e * CAP; float* GATEV = (float*)(p.ws + WS_GATEV) + e * CAP; int* SLOTOF = (int*)(p.ws + WS_SLOTOF);
    for (int i0 = 0; i0 < SEQ; i0 += 8 * NTHREADS) { unsigned kk[8];
#pragma unroll
        for (int q = 0; q < 8; ++q) kk[q] = aff[i0 + q * NTHREADS + tid];
#pragma unroll
        for (int q = 0; q < 8; ++q) keys[i0 + q * NTHREADS + tid] = kk[q]; }
    unsigned prefix = 0, krem = CAP;
    for (int pass = 0; pass < 4; ++pass) {
        const int shift = 24 - 8 * pass;
        if (tid < 256) hist[tid] = 0;
        __syncthreads();
        for (int i = tid; i < SEQ; i += NTHREADS) { const unsigned k = keys[i]; if (pass == 0 || (k >> (shift + 8)) == prefix) __hip_atomic_fetch_add(&hist[(k >> shift) & 255], 1u, __ATOMIC_RELAXED, __HIP_MEMORY_SCOPE_WORKGROUP); }
        __syncthreads();
        if (tid < 64) {
            unsigned c[4], tot = 0;
#pragma unroll
            for (int q = 0; q < 4; ++q) { c[q] = hist[255 - 4 * lane - q]; tot += c[q]; }
            unsigned incl = tot;
#pragma unroll
            for (int o = 1; o < 64; o <<= 1) { const unsigned n = __shfl_up(incl, o); if (lane >= o) incl += n; }
            const unsigned excl = incl - tot;
            if (excl < krem && krem <= incl) { unsigned run = excl;
#pragma unroll
                for (int q = 0; q < 4; ++q) { if (run < krem && krem <= run + c[q]) { ctl[0] = 255 - 4 * lane - q; ctl[1] = krem - run; ctl[3] = c[q]; } run += c[q]; } }
        }
        __syncthreads();
        prefix = (prefix << 8) | ctl[0]; krem = ctl[1];
        __syncthreads();
    }
    const unsigned T = prefix; const unsigned n_eq = ctl[3]; const bool all_eq = (n_eq == krem); const unsigned cnt_gt = CAP - krem;
    if (tid == 0) ctl[2] = 0;
    __syncthreads();
    for (int i = tid; i < SEQ; i += NTHREADS) { const unsigned k = keys[i];
        if (k > T || (k == T && all_eq)) { const unsigned slot = __hip_atomic_fetch_add(&ctl[2], 1u, __ATOMIC_RELAXED, __HIP_MEMORY_SCOPE_WORKGROUP); IDX[slot] = i; GATEV[slot] = __uint_as_float(k); SLOTOF[i * NE + e] = e * CAP + (int)slot; }
        else if (k != T) SLOTOF[i * NE + e] = -1; }
    __syncthreads();
    if (!all_eq && tid == 0) { unsigned r = 0;
        for (int i = 0; i < SEQ; ++i) if (keys[i] == T) { if (r < krem) { const unsigned slot = cnt_gt + r; IDX[slot] = i; GATEV[slot] = __uint_as_float(T); SLOTOF[i * NE + e] = e * CAP + (int)slot; ++r; } else SLOTOF[i * NE + e] = -1; } }
}
__device__ void phase_combine(const Params& p, int l, float* outp) {
    const int tid = fresh_tid(), lane = tid & 63, wv = tid >> 6;
    bf16_t* XB = (bf16_t*)(p.ws + WS_XB); const bf16_t* YB = (const bf16_t*)(p.ws + WS_YB); const int* SLOTOF = (const int*)(p.ws + WS_SLOTOF);
    const float* g = p.ln_ffn_g + l * DM; const float* b = p.ln_ffn_b + l * DM;
    f32x4 gv[4], bv[4];
#pragma unroll
    for (int j = 0; j < 4; ++j) { gv[j] = *(const f32x4*)(g + lane * 4 + 256 * j); bv[j] = *(const f32x4*)(b + lane * 4 + 256 * j); }
    const int rstride = gridDim.x * 8;
    int nslot = 0; u32x2 nraw[4];
    { const int row0 = blockIdx.x * 8 + wv;
      if (row0 < SEQ) { nslot = SLOTOF[row0 * NE + (lane & 15)];
#pragma unroll
          for (int j = 0; j < 4; ++j) nraw[j] = *(const u32x2*)(XB + (size_t)row0 * DM + lane * 4 + 256 * j); } }
    for (int row = blockIdx.x * 8 + wv; row < SEQ; row += rstride) {
        f32x4 v[4];
        const int myslot = nslot;
#pragma unroll
        for (int j = 0; j < 4; ++j) { const u32x2 w = nraw[j]; v[j] = (f32x4){bf_lo(w.x), bf_hi(w.x), bf_lo(w.y), bf_hi(w.y)} * ALPHA; }
        if (row + rstride < SEQ) { nslot = SLOTOF[(row + rstride) * NE + (lane & 15)];
#pragma unroll
            for (int j = 0; j < 4; ++j) nraw[j] = *(const u32x2*)(XB + (size_t)(row + rstride) * DM + lane * 4 + 256 * j); }
        unsigned long long em = __ballot(myslot >= 0) & 0xffffull;
        while (em) {
            int sl[4];
#pragma unroll
            for (int k = 0; k < 4; ++k) { sl[k] = -1; if (em) { const int e = __builtin_ctzll(em); em &= em - 1; sl[k] = __builtin_amdgcn_readlane(myslot, e); } }
            u32x2 yw[4][4];
#pragma unroll
            for (int k = 0; k < 4; ++k) if (sl[k] >= 0) {
#pragma unroll
                for (int j = 0; j < 4; ++j) yw[k][j] = *(const u32x2*)(YB + (size_t)sl[k] * DM + lane * 4 + 256 * j); }
#pragma unroll
            for (int k = 0; k < 4; ++k) if (sl[k] >= 0) {
#pragma unroll
                for (int j = 0; j < 4; ++j) { const u32x2 w = yw[k][j]; v[j][0] += bf_lo(w.x); v[j][1] += bf_hi(w.x); v[j][2] += bf_lo(w.y); v[j][3] += bf_hi(w.y); } }
        }
        float s = 0.f;
#pragma unroll
        for (int j = 0; j < 4; ++j) s += (v[j][0] + v[j][1]) + (v[j][2] + v[j][3]);
        const float mean = wave_sum(s) * (1.0f / 1024.0f); float q = 0.f;
#pragma unroll
        for (int j = 0; j < 4; ++j) { v[j] = v[j] - mean; q += (v[j][0] * v[j][0] + v[j][1] * v[j][1]) + (v[j][2] * v[j][2] + v[j][3] * v[j][3]); }
        const float rstd = rsqrtf(wave_sum(q) * (1.0f / 1024.0f) + 1e-5f);
#pragma unroll
        for (int j = 0; j < 4; ++j) { v[j] = v[j] * rstd * gv[j] + bv[j];
            if (l == NL - 1) *(f32x4*)(outp + (size_t)row * DM + lane * 4 + 256 * j) = v[j];
            else { u32x2 w; w.x = cvt_pk_bf16(v[j][0], v[j][1]); w.y = cvt_pk_bf16(v[j][2], v[j][3]); *(u32x2*)(XB + (size_t)row * DM + lane * 4 + 256 * j) = w; } }
    }
}

constexpr int PH_PER_LAYER = 11, N_PHASES = 1 + NL * PH_PER_LAYER;

__device__ __forceinline__ void run_phase(const Params& p, int ph, LAS unsigned char* lds) {
    unsigned char* ws = p.ws;
    if (ph == 0) { phase_convert(p, lds); return; }
    const int l = (ph - 1) / PH_PER_LAYER, k = (ph - 1) % PH_PER_LAYER;
    bf16_t* PROJ = (bf16_t*)(ws + WS_PROJ); bf16_t* YCAT = (bf16_t*)(ws + WS_YCAT);
    switch (k) {
    case 0: {
        Sched S; S.A = (const char*)(ws + WS_XB); S.idx = nullptr; S.B0 = (const char*)(ws + WS_WIN) + (size_t)l * NP * 1024 * 2; S.b1off = (size_t)HALF * 1024 * 2; S.bstrideE = 0; S.bRowsPerPn = 256; S.K = 1024; S.init(SEQ / BM, NP / BM);
        EpiProj E{PROJ, (u32x4*)(ws + WS_GT)}; gemm_phase<false>(lds, S, E); } break;
    case 1: { attn_mfma(p, l, PROJ, YCAT, lds); conv_naive(p, l, PROJ, YCAT); __syncthreads(); gla_pass1(p, l, PROJ, lds); } break;
    case 2: gla_scan(p); break;
    case 3: gla_pass2(p, l, PROJ, YCAT, lds); break;
    case 4: {
        Sched S; S.A = (const char*)YCAT; S.idx = nullptr; S.B0 = (const char*)(ws + WS_WMRG) + (size_t)l * 3 * 1024 * 512 * 2; S.b1off = (size_t)HALF * 512 * 2; S.bstrideE = 0; S.bRowsPerPn = 256; S.K = 512; S.init(SEQ / BM, DM / BM);
        S.nbr = 3; S.abr = (size_t)SEQ * 512 * 2; S.bbr = (size_t)1024 * 512 * 2;
        EpiMerge E{(const u32x4*)(ws + WS_GT), (bf16_t*)(ws + WS_MERGED)}; gemm_phase<false>(lds, S, E); } break;
    case 5: {
        Sched S; S.A = (const char*)(ws + WS_MERGED); S.idx = nullptr; S.B0 = (const char*)(ws + WS_WOUT) + (size_t)l * 1024 * 1024 * 2; S.b1off = (size_t)HALF * 1024 * 2; S.bstrideE = 0; S.bRowsPerPn = 256; S.K = 1024; S.init(SEQ / BM, DM / BM);
        EpiWout E{(const bf16_t*)(ws + WS_XB), (bf16_t*)(ws + WS_XA)}; gemm_phase<false>(lds, S, E); } break;
    case 6: phase_ln1_router(p, l, lds); break;
    case 7: phase_topk(p, l, lds); break;
    case 8: {
        Sched S; S.A = (const char*)(ws + WS_XB); S.idx = (const int*)(ws + WS_IDX); S.B0 = (const char*)(ws + WS_WG) + (size_t)l * NE * FF * 1024 * 2; S.b1off = WS_WU - WS_WG;
        S.bstrideE = (size_t)FF * 1024 * 2; S.bRowsPerPn = 128; S.K = 1024; S.init(NSLOT / BM, FF / HALF);
        EpiMoe1 E{(bf16_t*)(ws + WS_H)}; gemm_phase<true>(lds, S, E); } break;
    case 9: {
        Sched S; S.A = (const char*)(ws + WS_H); S.idx = nullptr; S.B0 = (const char*)(ws + WS_WD) + (size_t)l * NE * FF * 1024 * 2; S.b1off = (size_t)HALF * FF * 2;
        S.bstrideE = (size_t)FF * 1024 * 2; S.bRowsPerPn = 256; S.K = FF; S.init(NSLOT / BM, DM / BM);
        EpiMoe2 E{(const float*)(ws + WS_GATEV), (bf16_t*)(ws + WS_YB)}; gemm_phase<false>(lds, S, E); } break;
    case 10: phase_combine(p, l, p.out); break;
    }
}

__device__ __forceinline__ void grid_barrier(unsigned* ctl, unsigned k) {
    asm volatile("s_waitcnt vmcnt(0)" ::: "memory");
    __syncthreads();
    if (threadIdx.x == 0) {
        const unsigned g = blockIdx.x & 7u, G = gridDim.x, members = (G - g + 7u) >> 3, ngroups = G < 8u ? G : 8u;
        __builtin_amdgcn_fence(__ATOMIC_RELEASE, "agent");
        asm volatile("s_waitcnt vmcnt(0)" ::: "memory");
        const unsigned old = __hip_atomic_fetch_add(ctl + 32 * g, 1u, __ATOMIC_RELAXED, __HIP_MEMORY_SCOPE_AGENT);
        if (old == k * members - 1u) {
            const unsigned old2 = __hip_atomic_fetch_add(ctl + 256, 1u, __ATOMIC_RELAXED, __HIP_MEMORY_SCOPE_AGENT);
            if (old2 == k * ngroups - 1u) {
                for (unsigned q = 0; q < ngroups; ++q) __hip_atomic_store(ctl + 512 + 32 * q, k, __ATOMIC_RELAXED, __HIP_MEMORY_SCOPE_AGENT);
            }
        }
        while (__hip_atomic_load(ctl + 512 + 32 * g, __ATOMIC_RELAXED, __HIP_MEMORY_SCOPE_AGENT) < k) __builtin_amdgcn_s_sleep(1);
        __builtin_amdgcn_fence(__ATOMIC_ACQUIRE, "agent");
        asm volatile("s_waitcnt vmcnt(0)" ::: "memory");
    }
    __syncthreads();
}
__global__ void __launch_bounds__(NTHREADS, 2) mega(Params p) {
    extern __shared__ __attribute__((aligned(16))) unsigned char lds_raw[];
    LAS unsigned char* lds = (LAS unsigned char*)lds_raw;
    cg::grid_group grid = cg::this_grid();
    for (int ph = p.ph_lo; ph < p.ph_hi; ++ph) {
        if (ph > p.ph_lo) { if (p.ph_hi > 4096) grid.sync();   else grid_barrier((unsigned*)p.ws, (unsigned)(ph - p.ph_lo)); }
#ifdef DUPMASK
        { const int kk = ph == 0 ? 11 : (ph - 1) % PH_PER_LAYER; if ((DUPMASK >> kk) & 1) { run_phase(p, ph, lds); __syncthreads(); } }
#endif
        run_phase(p, ph, lds);
    }
}
}

extern "C" void kernel_launch(void* const* d_in, const int* in_sizes, int n_in, void* d_out, int out_size, void* d_ws, size_t ws_size, hipStream_t stream) {
    static int grid = 0;
    if (grid == 0) {
        if (n_in != 19 || out_size != SEQ * DM || ws_size < WS_END) { fprintf(stderr, "kernel_launch: unexpected shapes: n_in %d out %d ws %zu (need %zu)\n", n_in, out_size, ws_size, (size_t)WS_END); grid = -1; return; }
        int dev = 0, cus = 0, per_cu = 0;
        hipGetDevice(&dev); hipDeviceGetAttribute(&cus, hipDeviceAttributeMultiprocessorCount, dev);
        if (hipFuncSetAttribute((const void*)mega, hipFuncAttributeMaxDynamicSharedMemorySize, LDS_BYTES) != hipSuccess) { fprintf(stderr, "kernel_launch: hipFuncSetAttribute failed\n"); grid = -1; return; }
        if (hipOccupancyMaxActiveBlocksPerMultiprocessor(&per_cu, (const void*)mega, NTHREADS, LDS_BYTES) != hipSuccess || per_cu < 1) { fprintf(stderr, "kernel_launch: occupancy query failed (%d)\n", per_cu); per_cu = 1; }
        (void)hipGetLastError();
        grid = cus * 1;
    }
    if (grid < 0) return;
    Params p{};
    p.x = (const float*)d_in[0]; p.w_in = (const float*)d_in[1]; p.attn_sink = (const float*)d_in[2]; p.conv_w = (const float*)d_in[3]; p.gw2 = (const float*)d_in[4]; p.gb = (const float*)d_in[5]; p.gng = (const float*)d_in[6];
    p.wba = (const float*)d_in[7]; p.wbc = (const float*)d_in[8]; p.wbg = (const float*)d_in[9]; p.w_out = (const float*)d_in[10]; p.ln_mix_g = (const float*)d_in[11]; p.ln_mix_b = (const float*)d_in[12];
    p.router_w = (const float*)d_in[13]; p.ewg = (const float*)d_in[14]; p.ewu = (const float*)d_in[15]; p.ewd = (const float*)d_in[16]; p.ln_ffn_g = (const float*)d_in[17]; p.ln_ffn_b = (const float*)d_in[18];
    p.out = (float*)d_out; p.ws = (unsigned char*)d_ws;
#if ONE_LAUNCH
    p.ph_lo = 0; p.ph_hi = N_PHASES;
    (void)hipMemsetAsync(d_ws, 0, 4096, stream);
    void* args[] = {&p};
    hipError_t e = hipLaunchCooperativeKernel((const void*)mega, dim3(grid), dim3(NTHREADS), args, LDS_BYTES, stream);
    if (e != hipSuccess) fprintf(stderr, "cooperative launch failed: %s (grid %d)\n", hipGetErrorString(e), grid);
#else
    for (int ph = 0; ph < N_PHASES; ++ph) { p.ph_lo = ph; p.ph_hi = ph + 1; hipLaunchKernelGGL(mega, dim3(grid), dim3(NTHREADS), LDS_BYTES, stream, p); }
#endif
}
```

```cpp
#include <hip/hip_runtime.h>
#include <hip/hip_cooperative_groups.h>
#include <cstdio>
namespace cg = cooperative_groups;

#ifndef ONE_LAUNCH
#define ONE_LAUNCH 1
#endif

#define LAS __attribute__((address_space(3)))
typedef unsigned short bf16_t;
typedef short bf16x8 __attribute__((ext_vector_type(8)));
typedef float f32x4 __attribute__((ext_vector_type(4)));
typedef float f32x2 __attribute__((ext_vector_type(2)));
typedef unsigned u32x4 __attribute__((ext_vector_type(4)));
typedef unsigned u32x2 __attribute__((ext_vector_type(2)));

namespace {
constexpr int SEQ = 16384, DM = 1024, NIN = 6944, NP = 7168, NL = 2;
constexpr int MG = 0, AQ = 3072, AK = 3584, AV = 3712, CH = 3840, CB = 4352, CC = 4864, GQ = 5376, GK = 5632, GV = 5888, GR = 6400, GLR = 6912;
constexpr int NE = 16, FF = 2048, CAP = 2048, NSLOT = NE * CAP;
constexpr int KCAT = 1536;
constexpr float ALPHA = 1.41421356237309515f;
constexpr int NSEG = 64, SEGLEN = 256;
constexpr int NTHREADS = 512;
constexpr int LDS_BYTES = 131072;

constexpr size_t al(size_t x) { return (x + 4095) & ~(size_t)4095; }
constexpr size_t WS_WIN = 4096;
constexpr size_t WS_WMRG = WS_WIN + al((size_t)NL * NP * 1024 * 2);
constexpr size_t WS_WOUT = WS_WMRG + al((size_t)NL * 1024 * KCAT * 2);
constexpr size_t WS_WG = WS_WOUT + al((size_t)NL * 1024 * 1024 * 2);
constexpr size_t WS_WU = WS_WG + al((size_t)NL * NE * FF * 1024 * 2);
constexpr size_t WS_WD = WS_WU + al((size_t)NL * NE * FF * 1024 * 2);
constexpr size_t WS_XB = WS_WD + al((size_t)NL * NE * FF * 1024 * 2);
constexpr size_t WS_XA = WS_XB + al((size_t)SEQ * DM * 2);
constexpr size_t WS_PROJ = WS_XA + al((size_t)SEQ * DM * 4);
constexpr size_t WS_H = WS_PROJ;
constexpr size_t WS_YB = WS_PROJ + (size_t)NSLOT * FF * 2;
constexpr size_t WS_YCAT = WS_PROJ + al((size_t)SEQ * NP * 2);
constexpr size_t WS_MERGED = WS_YCAT + al((size_t)SEQ * KCAT * 2);
constexpr size_t WS_AFF = WS_MERGED + al((size_t)SEQ * DM * 2);
constexpr size_t WS_IDX = WS_AFF + al((size_t)NE * SEQ * 4);
constexpr size_t WS_GATEV = WS_IDX + al((size_t)NSLOT * 4);
constexpr size_t WS_SLOTOF = WS_GATEV + al((size_t)NSLOT * 4);
constexpr size_t WS_GE = WS_SLOTOF + al((size_t)SEQ * NE * 4);
constexpr size_t WS_GSIN = WS_GE + al((size_t)NSEG * 2 * 32768 * 4);
constexpr size_t WS_GASEG = WS_GSIN + al((size_t)NSEG * 2 * 32768 * 4);
constexpr size_t WS_OF = WS_GASEG + al((size_t)NSEG * 2 * 256 * 4);
constexpr size_t WS_OF2 = WS_OF + al((size_t)SEQ * 512 * 4);
constexpr size_t WS_GT = WS_OF2 + al((size_t)SEQ * 512 * 4);
constexpr size_t WS_END = WS_GT + al((size_t)3 * 64 * 4 * 16 * 512 * 16);
static_assert((size_t)NSLOT * FF * 2 + (size_t)NSLOT * DM * 2 <= (size_t)SEQ * NP * 2, "H + YB must fit in PROJ");
static_assert(WS_END <= (size_t)1073741824, "workspace map must fit 4 x the largest input tensor (1 GiB)");

struct Params {
    const float* x; const float* w_in; const float* attn_sink; const float* conv_w; const float* gw2; const float* gb; const float* gng;
    const float* wba; const float* wbc; const float* wbg; const float* w_out; const float* ln_mix_g; const float* ln_mix_b;
    const float* router_w; const float* ewg; const float* ewu; const float* ewd; const float* ln_ffn_g; const float* ln_ffn_b;
    float* out; unsigned char* ws; int ph_lo, ph_hi;
};

__device__ __forceinline__ unsigned cvt_pk_bf16(float lo, float hi) { unsigned r; asm("v_cvt_pk_bf16_f32 %0, %1, %2" : "=v"(r) : "v"(lo), "v"(hi)); return r; }
typedef __bf16 bf16v2_t __attribute__((ext_vector_type(2)));
__device__ __forceinline__ unsigned cvt_pk_bf16_mfma(float lo, float hi) { const f32x2 v = {lo, hi}; return __builtin_bit_cast(unsigned, __builtin_convertvector(v, bf16v2_t)); }
__device__ __forceinline__ float bf_lo(unsigned w) { return __uint_as_float(w << 16); }
__device__ __forceinline__ float bf_hi(unsigned w) { return __uint_as_float(w & 0xffff0000u); }
__device__ __forceinline__ float bf2f(bf16_t b) { return __uint_as_float(((unsigned)b) << 16); }
__device__ __forceinline__ int fresh_tid() { int t = threadIdx.x; asm volatile("" : "+v"(t)); return t; }
__device__ __forceinline__ float wave_sum(float v) {
#pragma unroll
    for (int o = 32; o >= 1; o >>= 1) v += __shfl_xor(v, o);
    return v;
}

constexpr int BM = 256, BK = 64, HALF = 128, HTB = HALF * BK * 2, NXCD = 8, WGM = 8;
__device__ __forceinline__ int lds_byte(int r, int c) { const int st = (r >> 4) * 2 + (c >> 5), rr = r & 15, cc = c & 31, ob = rr * 64 + cc * 2; return st * 1024 + (ob ^ (((ob >> 9) & 1) << 5)); }
__device__ __forceinline__ void stage_rc(int b, int& R, int& C) { const int st = b / 1024, sb = b % 1024, swz = sb ^ (((sb >> 9) & 1) << 5); R = (st >> 1) * 16 + swz / 64; C = (st & 1) * 32 + (swz % 64) / 2; }
__device__ __forceinline__ int perm32(int rho) { const int n = rho >> 4, i = rho & 15; return 8 * (i >> 2) + 4 * n + (i & 3); }

struct Unit { int pm, pn, br; };

struct Sched {
    const char* A; const int* idx; const char* B0; size_t b1off; size_t bstrideE; int bRowsPerPn; int K;
    int nbr; size_t abr, bbr;
    int nM, nN, nwg, G, c;
    __device__ __forceinline__ void init(int nM_, int nN_) { nM = nM_; nN = nN_; nwg = nM * nN; G = gridDim.x; c = blockIdx.x; nbr = 1; abr = 0; bbr = 0; }
    __device__ __forceinline__ bool next(int i0, Unit& u) const {
        const int i = i0 / nbr; u.br = i0 - i * nbr;
        const long L = (long)i * G + c; if (L >= nwg) return false;
        int wgid = (int)L; { const int q = nwg / NXCD, r = nwg % NXCD, xcd = wgid % NXCD, off = wgid / NXCD; wgid = (xcd < r ? xcd * (q + 1) : r * (q + 1) + (xcd - r) * q) + off; }
        const int nig = WGM * nN, gid = wgid / nig, fm = gid * WGM, gsz = (nM - fm) < WGM ? (nM - fm) : WGM;
        u.pm = fm + ((wgid % nig) % gsz); u.pn = (wgid % nig) / gsz; return true;
    }
    __device__ __forceinline__ const char* bptr(const Unit& u) const {
        const size_t eo = bstrideE ? (size_t)(u.pm >> 3) * bstrideE : 0;
        return B0 + eo + (size_t)u.pn * bRowsPerPn * K * 2 + (size_t)u.br * bbr;
    }
};

struct EpiStoreBf16 {
    static constexpr bool PERM = true, MID = false, KEEP = false;
    bf16_t* O; int ldc;
    __device__ __forceinline__ void operator()(const f32x4 (&acc)[2][2][4][2], const Unit& u, int wr, int wc, int fr, int fq) const {
        const int row0 = u.pm * BM + wr * 64 + fr, col0 = u.pn * BM + wc * 32 + 8 * fq;
#pragma unroll
        for (int ai = 0; ai < 2; ++ai)
#pragma unroll
            for (int m = 0; m < 4; ++m) { bf16_t* rowp = O + (size_t)(row0 + ai * HALF + m * 16) * ldc + col0;
#pragma unroll
                for (int bj = 0; bj < 2; ++bj) { const f32x4 v0 = acc[ai][bj][m][0], v1 = acc[ai][bj][m][1];
                    u32x4 w; w.x = cvt_pk_bf16(v0[0], v0[1]); w.y = cvt_pk_bf16(v0[2], v0[3]); w.z = cvt_pk_bf16(v1[0], v1[1]); w.w = cvt_pk_bf16(v1[2], v1[3]);
                    *(u32x4*)(rowp + bj * HALF) = w; } }
    }
};
struct EpiProj {
    static constexpr bool PERM = true, MID = false, KEEP = false;
    bf16_t* O; u32x4* GT;
    __device__ __forceinline__ void operator()(const f32x4 (&acc)[2][2][4][2], const Unit& u, int wr, int wc, int fr, int fq) const {
        if (u.pn < 12) {
            const int tidl = (wr * 4 + wc) * 64 + fq * 16 + fr;
            u32x4* gp = GT + ((size_t)(((u.pn >> 2) * 64 + u.pm) * 4 + (u.pn & 3)) * 16) * 512 + tidl;
#pragma unroll
            for (int ai = 0; ai < 2; ++ai)
#pragma unroll
                for (int m = 0; m < 4; ++m)
#pragma unroll
                    for (int bj = 0; bj < 2; ++bj) { const f32x4 v0 = acc[ai][bj][m][0], v1 = acc[ai][bj][m][1]; float g[8];
#pragma unroll
                        for (int j = 0; j < 4; ++j) { g[j] = __builtin_amdgcn_rcpf(1.0f + __expf(-v0[j])); g[4 + j] = __builtin_amdgcn_rcpf(1.0f + __expf(-v1[j])); }
                        u32x4 w; w.x = cvt_pk_bf16(g[0], g[1]); w.y = cvt_pk_bf16(g[2], g[3]); w.z = cvt_pk_bf16(g[4], g[5]); w.w = cvt_pk_bf16(g[6], g[7]);
                        gp[(size_t)((ai * 4 + m) * 2 + bj) * 512] = w; }
        } else { EpiStoreBf16 st{O, NP}; st(acc, u, wr, wc, fr, fq); }
    }
};
struct EpiMerge {
    static constexpr bool PERM = true, MID = false, KEEP = true;
    const u32x4* GT; bf16_t* O;
    __device__ __forceinline__ void operator()(f32x4 (&acc)[2][2][4][2], const Unit& u, int wr, int wc, int fr, int fq) const {
        const int row0 = u.pm * BM + wr * 64 + fr, col0 = u.pn * BM + wc * 32 + 8 * fq;
        const bool fin = (u.br == 2);
        const int tidl = (wr * 4 + wc) * 64 + fq * 16 + fr;
        const u32x4* gn = GT + ((size_t)((u.br * 64 + u.pm) * 4 + u.pn) * 16) * 512 + tidl;
        const u32x4* gd = gn + (size_t)64 * 4 * 16 * 512;
#pragma unroll
        for (int ai = 0; ai < 2; ++ai)
#pragma unroll
            for (int m = 0; m < 4; ++m) { const size_t row = (size_t)(row0 + ai * HALF + m * 16);
#pragma unroll
                for (int bj = 0; bj < 2; ++bj) { const size_t so = (size_t)((ai * 4 + m) * 2 + bj) * 512;
                    const u32x4 zn = gn[so]; u32x4 zd = zn; if (!fin) zd = gd[so];
                    float f[8];
#pragma unroll
                    for (int q = 0; q < 4; ++q) { f[2 * q] = fin ? bf_lo(zn[q]) : bf_lo(zn[q]) * __builtin_amdgcn_rcpf(bf_lo(zd[q])); f[2 * q + 1] = fin ? bf_hi(zn[q]) : bf_hi(zn[q]) * __builtin_amdgcn_rcpf(bf_hi(zd[q])); }
                    f32x4 v0 = acc[ai][bj][m][0], v1 = acc[ai][bj][m][1];
                    v0[0] *= f[0]; v0[1] *= f[1]; v0[2] *= f[2]; v0[3] *= f[3]; v1[0] *= f[4]; v1[1] *= f[5]; v1[2] *= f[6]; v1[3] *= f[7];
                    acc[ai][bj][m][0] = v0; acc[ai][bj][m][1] = v1;
                    if (fin) { u32x4 w; w.x = cvt_pk_bf16(v0[0], v0[1]); w.y = cvt_pk_bf16(v0[2], v0[3]); w.z = cvt_pk_bf16(v1[0], v1[1]); w.w = cvt_pk_bf16(v1[2], v1[3]);
                        *(u32x4*)(O + row * DM + col0 + bj * HALF) = w; } }
                if (m & 1) { asm volatile("" ::: "memory"); __builtin_amdgcn_sched_barrier(0); } }
    }
};
struct EpiWout {
    static constexpr bool PERM = true, MID = false, KEEP = false;
    const bf16_t* xres; bf16_t* O;
    __device__ __forceinline__ void operator()(const f32x4 (&acc)[2][2][4][2], const Unit& u, int wr, int wc, int fr, int fq) const {
        const int row0 = u.pm * BM + wr * 64 + fr, col0 = u.pn * BM + wc * 32 + 8 * fq;
#pragma unroll
        for (int ai = 0; ai < 2; ++ai) {
            u32x4 xrr[4][2];
#pragma unroll
            for (int m = 0; m < 4; ++m)
#pragma unroll
                for (int bj = 0; bj < 2; ++bj) xrr[m][bj] = *(const u32x4*)(xres + (size_t)(row0 + ai * HALF + m * 16) * DM + col0 + bj * HALF);
#pragma unroll
            for (int m = 0; m < 4; ++m) { const size_t off = (size_t)(row0 + ai * HALF + m * 16) * DM + col0;
#pragma unroll
                for (int bj = 0; bj < 2; ++bj) { const u32x4 xr = xrr[m][bj];
                    const f32x4 v0 = acc[ai][bj][m][0], v1 = acc[ai][bj][m][1];
                    u32x4 w; w.x = cvt_pk_bf16(fmaf(bf_lo(xr.x), ALPHA, v0[0]), fmaf(bf_hi(xr.x), ALPHA, v0[1])); w.y = cvt_pk_bf16(fmaf(bf_lo(xr.y), ALPHA, v0[2]), fmaf(bf_hi(xr.y), ALPHA, v0[3]));
                    w.z = cvt_pk_bf16(fmaf(bf_lo(xr.z), ALPHA, v1[0]), fmaf(bf_hi(xr.z), ALPHA, v1[1])); w.w = cvt_pk_bf16(fmaf(bf_lo(xr.w), ALPHA, v1[2]), fmaf(bf_hi(xr.w), ALPHA, v1[3]));
                    *(u32x4*)(O + off + bj * HALF) = w; } }
            asm volatile("" ::: "memory"); }
    }
};
struct EpiMoe1 {
    static constexpr bool PERM = true, MID = false, KEEP = false;
    bf16_t* O;
    __device__ __forceinline__ void operator()(const f32x4 (&acc)[2][2][4][2], const Unit& u, int wr, int wc, int fr, int fq) const {
        const int row0 = u.pm * BM + wr * 64 + fr, col0 = u.pn * HALF + wc * 32 + 8 * fq;
#pragma unroll
        for (int ai = 0; ai < 2; ++ai)
#pragma unroll
            for (int m = 0; m < 4; ++m) { bf16_t* rowp = O + (size_t)(row0 + ai * HALF + m * 16) * FF + col0;
                float h[8];
#pragma unroll
                for (int n = 0; n < 2; ++n)
#pragma unroll
                    for (int j = 0; j < 4; ++j) { const float g = acc[ai][0][m][n][j], up = acc[ai][1][m][n][j]; h[n * 4 + j] = g * __builtin_amdgcn_rcpf(1.0f + __expf(-g)) * up; }
                u32x4 w; w.x = cvt_pk_bf16(h[0], h[1]); w.y = cvt_pk_bf16(h[2], h[3]); w.z = cvt_pk_bf16(h[4], h[5]); w.w = cvt_pk_bf16(h[6], h[7]);
                *(u32x4*)rowp = w; }
    }
};
struct EpiMoe2 {
    static constexpr bool PERM = true, MID = false, KEEP = false;
    const float* gatev; bf16_t* O;
    __device__ __forceinline__ void operator()(const f32x4 (&acc)[2][2][4][2], const Unit& u, int wr, int wc, int fr, int fq) const {
        const int row0 = u.pm * BM + wr * 64 + fr, col0 = u.pn * BM + wc * 32 + 8 * fq;
        float gvv[2][4];
#pragma unroll
        for (int ai = 0; ai < 2; ++ai)
#pragma unroll
            for (int m = 0; m < 4; ++m) gvv[ai][m] = gatev[row0 + ai * HALF + m * 16];
#pragma unroll
        for (int ai = 0; ai < 2; ++ai)
#pragma unroll
            for (int m = 0; m < 4; ++m) { const int row = row0 + ai * HALF + m * 16; const float gv = gvv[ai][m]; bf16_t* rowp = O + (size_t)row * DM + col0;
#pragma unroll
                for (int bj = 0; bj < 2; ++bj) { const f32x4 v0 = acc[ai][bj][m][0] * gv, v1 = acc[ai][bj][m][1] * gv;
                    u32x4 w; w.x = cvt_pk_bf16(v0[0], v0[1]); w.y = cvt_pk_bf16(v0[2], v0[3]); w.z = cvt_pk_bf16(v1[0], v1[1]); w.w = cvt_pk_bf16(v1[2], v1[3]);
                    *(u32x4*)(rowp + bj * HALF) = w; } }
    }
};

template <bool GATHER, class Epi>
__device__ __forceinline__ void gemm_phase(LAS unsigned char* lds, const Sched& S, const Epi& E) {
    const int tid = fresh_tid(), wid = __builtin_amdgcn_readfirstlane(tid >> 6), lane = tid & 63, wr = wid >> 2, wc = wid & 3, fr = lane & 15, fq = lane >> 4;
    const int K = S.K, nt = K / BK;
    int R0, C0; unsigned voffA[2], voffB[2];
    { int R, C; stage_rc(tid * 16, R, C); R0 = R; C0 = C; }
#pragma unroll
    for (int i = 0; i < 2; ++i) { int R, C; stage_rc(tid * 16 + i * 8192, R, C); const int Rb = Epi::PERM ? ((R & ~31) + perm32(R & 31)) : R; voffA[i] = (unsigned)(R * K + C) * 2u; voffB[i] = (unsigned)(Rb * K + C) * 2u; }
    const size_t kstep = (size_t)(BK * 2);
    const size_t hstep = (size_t)HALF * K * 2;
    const size_t tstep = 2 * hstep;
    const size_t b1off = S.b1off;
    const unsigned ldsw = (unsigned)wid * 1024u;
    const int aoff = lds_byte(wr * 64 + fr, fq * 8), boff = lds_byte(wc * 32 + fr, fq * 8);
#define PG8_SA(b, h) (((b) * 2 + (h)) * HTB)
#define PG8_SB(b, h) ((4 + (b) * 2 + (h)) * HTB)
#define PG8_STAGE(bufoff, gbase, v0, v1) do { unsigned _v0 = (v0), _v1 = (v1); asm volatile("" : "+v"(_v0), "+v"(_v1)); \
        __builtin_amdgcn_global_load_lds((const unsigned*)((const char*)(gbase) + _v0), (LAS unsigned*)(lds + (bufoff) + ldsw), 16, 0, 0); \
        __builtin_amdgcn_global_load_lds((const unsigned*)((const char*)(gbase) + _v1), (LAS unsigned*)(lds + (bufoff) + ldsw + 8192), 16, 0, 0); } while (0)
#define PG8_STAGE_A(bufoff, gbase, h) do { if constexpr (GATHER) PG8_STAGE(bufoff, gbase, go[h][0], go[h][1]); else PG8_STAGE(bufoff, (gbase) + (h) * hstep, voffA[0], voffA[1]); } while (0)
#define PG8_LDA(dst, b, h) do { _Pragma("unroll") for (int m = 0; m < 4; ++m) _Pragma("unroll") for (int k = 0; k < 2; ++k) dst[m][k] = *(const LAS bf16x8*)(lds + PG8_SA(b, h) + aoff + m * 2048 + k * 1024); } while (0)
#define PG8_LDB(dst, b, h) do { _Pragma("unroll") for (int n = 0; n < 2; ++n) _Pragma("unroll") for (int k = 0; k < 2; ++k) dst[n][k] = *(const LAS bf16x8*)(lds + PG8_SB(b, h) + boff + n * 2048 + k * 1024); } while (0)
#define PG8_MMA(ai, bj, At, Bt) do { __builtin_amdgcn_s_setprio(1); _Pragma("unroll") for (int m = 0; m < 4; ++m) _Pragma("unroll") for (int n = 0; n < 2; ++n) _Pragma("unroll") for (int k = 0; k < 2; ++k) \
        acc[ai][bj][m][n] = __builtin_amdgcn_mfma_f32_16x16x32_bf16(Bt[n][k], At[m][k], acc[ai][bj][m][n], 0, 0, 0); __builtin_amdgcn_s_setprio(0); } while (0)
#define PG8_WAIT_V(n) asm volatile("s_waitcnt vmcnt(" #n ")" ::: "memory")
#define PG8_WAIT_L(n) asm volatile("s_waitcnt lgkmcnt(" #n ")" ::: "memory")
#define PG8_BAR __builtin_amdgcn_s_barrier()
#define PG8_SCHED __builtin_amdgcn_sched_barrier(0)
#define PG8_GOFFS(u) do { _Pragma("unroll") for (int h = 0; h < 2; ++h) _Pragma("unroll") for (int i = 0; i < 2; ++i) \
        go[h][i] = (unsigned)(S.idx[(u).pm * BM + h * HALF + R0 + 64 * i] * K + C0) * 2u; } while (0)
#define PG8_TRIP(LAST) do { \
            const char* a1 = cA + (size_t)(t + 1) * kstep; \
            const char* a2 = (LAST) ? nA : cA + (size_t)(t + 2) * kstep; const char* b2 = (LAST) ? nB : cB + (size_t)(t + 2) * kstep; \
            const char* a3 = a2 + kstep; const char* b3 = b2 + kstep; \
            PG8_LDB(B0, 0, 0); PG8_SCHED; PG8_LDA(At, 0, 0); PG8_STAGE_A(PG8_SA(1, 1), a1, 1); \
            PG8_WAIT_L(8); PG8_BAR; PG8_WAIT_L(0); PG8_MMA(0, 0, At, B0); PG8_BAR; PG8_SCHED; \
            if constexpr (GATHER) { if ((LAST) && has_next) PG8_GOFFS(nxt); } \
            PG8_LDB(B1, 0, 1); PG8_STAGE(PG8_SB(0, 0), b2, voffB[0], voffB[1]); \
            PG8_BAR; PG8_WAIT_L(0); PG8_MMA(0, 1, At, B1); PG8_BAR; \
            PG8_LDA(At, 0, 1); PG8_STAGE_A(PG8_SA(0, 0), a2, 0); \
            PG8_BAR; PG8_WAIT_L(0); PG8_MMA(1, 0, At, B0); PG8_BAR; PG8_SCHED; \
            PG8_STAGE(PG8_SB(0, 1), b2 + b1off, voffB[0], voffB[1]); \
            PG8_WAIT_V(6); PG8_BAR; PG8_MMA(1, 1, At, B1); PG8_BAR; \
            PG8_LDB(B0, 1, 0); PG8_SCHED; PG8_LDA(At, 1, 0); PG8_STAGE_A(PG8_SA(0, 1), a2, 1); \
            PG8_WAIT_L(8); PG8_BAR; PG8_WAIT_L(0); PG8_MMA(0, 0, At, B0); PG8_BAR; PG8_SCHED; \
            PG8_LDB(B1, 1, 1); PG8_STAGE(PG8_SB(1, 0), b3, voffB[0], voffB[1]); \
            PG8_BAR; PG8_WAIT_L(0); PG8_MMA(0, 1, At, B1); PG8_BAR; \
            PG8_LDA(At, 1, 1); PG8_STAGE_A(PG8_SA(1, 0), a3, 0); \
            PG8_BAR; PG8_WAIT_L(0); PG8_MMA(1, 0, At, B0); PG8_BAR; PG8_SCHED; \
            PG8_STAGE(PG8_SB(1, 1), b3 + b1off, voffB[0], voffB[1]); \
            PG8_WAIT_V(6); PG8_BAR; PG8_MMA(1, 1, At, B1); PG8_BAR; } while (0)
    Unit cur, nxt; int ui = 0;
    if (!S.next(0, cur)) return;
    f32x4 acc[2][2][4][2];
#pragma unroll
    for (int a = 0; a < 2; ++a)
#pragma unroll
        for (int b = 0; b < 2; ++b)
#pragma unroll
            for (int m = 0; m < 4; ++m)
#pragma unroll
                for (int n = 0; n < 2; ++n) acc[a][b][m][n] = (f32x4){0.f, 0.f, 0.f, 0.f};
    bf16x8 At[4][2], B0[2][2], B1[2][2];
    unsigned go[2][2] = {{0u, 0u}, {0u, 0u}};
    const char* cA = GATHER ? S.A : S.A + (size_t)cur.pm * tstep + (size_t)cur.br * S.abr; const char* cB = S.bptr(cur);
    if constexpr (GATHER) PG8_GOFFS(cur);
    PG8_STAGE(PG8_SB(0, 0), cB, voffB[0], voffB[1]); PG8_STAGE_A(PG8_SA(0, 0), cA, 0); PG8_STAGE(PG8_SB(0, 1), cB + b1off, voffB[0], voffB[1]); PG8_STAGE_A(PG8_SA(0, 1), cA, 1);
    if (wr == 1) PG8_BAR;
    PG8_WAIT_V(4); PG8_BAR;
    PG8_STAGE(PG8_SB(1, 0), cB + kstep, voffB[0], voffB[1]); PG8_STAGE_A(PG8_SA(1, 0), cA + kstep, 0); PG8_STAGE(PG8_SB(1, 1), cB + b1off + kstep, voffB[0], voffB[1]);
    PG8_WAIT_V(6); PG8_BAR;
    for (;;) {
        const bool has_next = S.next(ui + 1, nxt);
        const char* nA = cA; const char* nB = cB;
        if (has_next) { nA = GATHER ? S.A : S.A + (size_t)nxt.pm * tstep + (size_t)nxt.br * S.abr; nB = S.bptr(nxt); }
        int t = 0;
        for (; t < nt - 2; t += 2) PG8_TRIP(false);
        PG8_TRIP(true);
        E(acc, cur, wr, wc, fr, fq);
        PG8_WAIT_V(0);
        if (!has_next) break;
        if (!Epi::KEEP || nxt.br == 0)
#pragma unroll
        for (int a = 0; a < 2; ++a)
#pragma unroll
            for (int b = 0; b < 2; ++b)
#pragma unroll
                for (int m = 0; m < 4; ++m)
#pragma unroll
                    for (int n = 0; n < 2; ++n) acc[a][b][m][n] = (f32x4){0.f, 0.f, 0.f, 0.f};
        cur = nxt; cA = nA; cB = nB; ++ui;
    }
    PG8_WAIT_V(0);
    if (wr == 0) PG8_BAR;
    PG8_BAR;
#undef PG8_SA
#undef PG8_SB
#undef PG8_STAGE
#undef PG8_STAGE_A
#undef PG8_LDA
#undef PG8_LDB
#undef PG8_MMA
#undef PG8_WAIT_V
#undef PG8_WAIT_L
#undef PG8_BAR
#undef PG8_SCHED
#undef PG8_GOFFS
#undef PG8_TRIP
}

__device__ void cvt_job(LAS float* tile, const float* src, bf16_t* dst, int batch, int K, int N, int ldd, int kofs, size_t sbs, size_t dbs, int bid, int nb, int nshift = 0) {
    const int tid = fresh_tid();
    const int tk = K / 64, tn = (N + 63) / 64, per = tk * tn, total = batch * per;
    for (int gi = bid; gi * 4 < total; gi += nb) {
        f32x4 v[4][2];
#pragma unroll
        for (int q = 0; q < 4; ++q) { const int it = gi * 4 + q;
            v[q][0] = (f32x4){0.f, 0.f, 0.f, 0.f}; v[q][1] = (f32x4){0.f, 0.f, 0.f, 0.f};
            if (it < total) { const int b = it / per, r = it % per, k0 = (r / tn) * 64, n0 = (r % tn) * 64;
                const float* sp = src + (size_t)b * sbs + (size_t)k0 * N + n0; const int c4 = (tid & 15) * 4;
                if (n0 + c4 < N) { v[q][0] = *(const f32x4*)(sp + (size_t)(tid >> 4) * N + c4); v[q][1] = *(const f32x4*)(sp + (size_t)((tid >> 4) + 32) * N + c4); } } }
#pragma unroll
        for (int q = 0; q < 4; ++q)
#pragma unroll
            for (int j = 0; j < 2; ++j) { const int row = (tid >> 4) + 32 * j, c4 = (tid & 15) * 4; LAS float* tp = tile + q * (64 * 65) + row * 65 + c4;
                tp[0] = v[q][j][0]; tp[1] = v[q][j][1]; tp[2] = v[q][j][2]; tp[3] = v[q][j][3]; }
        __syncthreads();
#pragma unroll
        for (int q = 0; q < 4; ++q) { const int it = gi * 4 + q;
            if (it < total) { const int b = it / per, r = it % per, k0 = (r / tn) * 64, n0 = (r % tn) * 64;
                const int n = tid >> 3, kc = (tid & 7) * 8;
                if (n0 + n < N) { float f[8];
#pragma unroll
                    for (int j = 0; j < 8; ++j) f[j] = tile[q * (64 * 65) + (kc + j) * 65 + n];
                    u32x4 w; w.x = cvt_pk_bf16(f[0], f[1]); w.y = cvt_pk_bf16(f[2], f[3]); w.z = cvt_pk_bf16(f[4], f[5]); w.w = cvt_pk_bf16(f[6], f[7]);
                    int nd = n0 + n + nshift; if (nd >= N) nd -= N;
                    *(u32x4*)(dst + (size_t)b * dbs + (size_t)nd * ldd + kofs + k0 + kc) = w; } } }
        __syncthreads();
    }
}
__device__ void phase_convert(const Params& p, LAS unsigned char* lds) {
    LAS float* tile = (LAS float*)lds;
    unsigned char* ws = p.ws;
    cvt_job(tile, p.w_in, (bf16_t*)(ws + WS_WIN), NL, 1024, NIN, 1024, 0, (size_t)1024 * NIN, (size_t)NP * 1024, (int)blockIdx.x, (int)gridDim.x, 3072);
    cvt_job(tile, p.wba, (bf16_t*)(ws + WS_WMRG), NL, 512, 1024, 512, 0, (size_t)512 * 1024, (size_t)3 * 1024 * 512, (int)((blockIdx.x + gridDim.x - 104 % gridDim.x) % gridDim.x), (int)gridDim.x);
    cvt_job(tile, p.wbc, (bf16_t*)(ws + WS_WMRG) + (size_t)1024 * 512, NL, 512, 1024, 512, 0, (size_t)512 * 1024, (size_t)3 * 1024 * 512, (int)((blockIdx.x + gridDim.x - 168 % gridDim.x) % gridDim.x), (int)gridDim.x);
    cvt_job(tile, p.wbg, (bf16_t*)(ws + WS_WMRG) + (size_t)2 * 1024 * 512, NL, 512, 1024, 512, 0, (size_t)512 * 1024, (size_t)3 * 1024 * 512, (int)((blockIdx.x + gridDim.x - 232 % gridDim.x) % gridDim.x), (int)gridDim.x);
    cvt_job(tile, p.w_out, (bf16_t*)(ws + WS_WOUT), NL, 1024, 1024, 1024, 0, (size_t)1024 * 1024, (size_t)1024 * 1024, (int)((blockIdx.x + gridDim.x - 40 % gridDim.x) % gridDim.x), (int)gridDim.x);
    cvt_job(tile, p.ewg, (bf16_t*)(ws + WS_WG), NE, 1024, FF, 1024, 0, (size_t)1024 * FF, (size_t)FF * 1024, (int)blockIdx.x, (int)gridDim.x);
    cvt_job(tile, p.ewu, (bf16_t*)(ws + WS_WU), NL * NE, 1024, FF, 1024, 0, (size_t)1024 * FF, (size_t)FF * 1024, (int)blockIdx.x, (int)gridDim.x);
    cvt_job(tile, p.ewd, (bf16_t*)(ws + WS_WD), NE, FF, 1024, FF, 0, (size_t)FF * 1024, (size_t)1024 * FF, (int)blockIdx.x, (int)gridDim.x);
    const f32x4* x4 = (const f32x4*)p.x; u32x2* xb = (u32x2*)(ws + WS_XB);
    { const size_t stride = (size_t)gridDim.x * NTHREADS;
      size_t i = (size_t)blockIdx.x * NTHREADS + fresh_tid();
      for (; i + 3 * stride < (size_t)SEQ * DM / 4; i += 4 * stride) {
        f32x4 v[4];
#pragma unroll
        for (int q = 0; q < 4; ++q) v[q] = x4[i + q * stride];
#pragma unroll
        for (int q = 0; q < 4; ++q) { u32x2 w; w.x = cvt_pk_bf16(v[q][0], v[q][1]); w.y = cvt_pk_bf16(v[q][2], v[q][3]); xb[i + q * stride] = w; } }
      for (; i < (size_t)SEQ * DM / 4; i += stride) { const f32x4 v = x4[i]; u32x2 w; w.x = cvt_pk_bf16(v[0], v[1]); w.y = cvt_pk_bf16(v[2], v[3]); xb[i] = w; } }
}

__device__ void attn_naive(const Params& p, int l, const bf16_t* proj, bf16_t* ycat) {
    for (int g = blockIdx.x * NTHREADS + fresh_tid(); g < 8 * SEQ; g += gridDim.x * NTHREADS) {
        const int hq = g >> 14, t = g & (SEQ - 1), hk = hq >> 2;
        float q[64], acc[64];
        { const u32x4* qp = (const u32x4*)(proj + (size_t)t * NP + AQ + hq * 64);
#pragma unroll
          for (int c = 0; c < 8; ++c) { const u32x4 w = qp[c];
#pragma unroll
              for (int e = 0; e < 4; ++e) { q[c * 8 + e * 2] = bf_lo(w[e]) * 0.125f; q[c * 8 + e * 2 + 1] = bf_hi(w[e]) * 0.125f; } } }
#pragma unroll
        for (int d = 0; d < 64; ++d) acc[d] = 0.f;
        const float slope = exp2f(-(float)(hq + 1)); const float sink = p.attn_sink[l * 8 + hq];
        float mx = sink, den = 1.0f;
        const int lo = t - 128 < 0 ? 0 : t - 128, hi = t + 128 > SEQ - 1 ? SEQ - 1 : t + 128;
        for (int s = lo; s <= hi; ++s) {
            const u32x4* kp = (const u32x4*)(proj + (size_t)s * NP + AK + hk * 64);
            float sc = 0.f;
#pragma unroll
            for (int c = 0; c < 8; ++c) { const u32x4 w = kp[c];
#pragma unroll
                for (int e = 0; e < 4; ++e) { sc += q[c * 8 + e * 2] * bf_lo(w[e]); sc += q[c * 8 + e * 2 + 1] * bf_hi(w[e]); } }
            const int dist = t > s ? t - s : s - t;
            sc -= slope * (float)dist;
            if (sc > mx) { const float f = __expf(mx - sc); den *= f;
#pragma unroll
                for (int d = 0; d < 64; ++d) acc[d] *= f;
                mx = sc; }
            const float pr = __expf(sc - mx); den += pr;
            const u32x4* vp = (const u32x4*)(proj + (size_t)s * NP + AV + hk * 64);
#pragma unroll
            for (int c = 0; c < 8; ++c) { const u32x4 w = vp[c];
#pragma unroll
                for (int e = 0; e < 4; ++e) { acc[c * 8 + e * 2] += pr * bf_lo(w[e]); acc[c * 8 + e * 2 + 1] += pr * bf_hi(w[e]); } }
        }
        const float inv = 1.0f / den;
        u32x4* op = (u32x4*)(ycat + (size_t)t * 512 + hq * 64);
#pragma unroll
        for (int c = 0; c < 8; ++c) { u32x4 w; w.x = cvt_pk_bf16(acc[c * 8] * inv, acc[c * 8 + 1] * inv); w.y = cvt_pk_bf16(acc[c * 8 + 2] * inv, acc[c * 8 + 3] * inv);
            w.z = cvt_pk_bf16(acc[c * 8 + 4] * inv, acc[c * 8 + 5] * inv); w.w = cvt_pk_bf16(acc[c * 8 + 6] * inv, acc[c * 8 + 7] * inv); op[c] = w; }
    }
}
__device__ void attn_mfma(const Params& p, int l, const bf16_t* proj, bf16_t* y0, LAS unsigned char* lds) {
    constexpr int KP = 72, VP = 392;
    LAS bf16_t* Ks = (LAS bf16_t*)lds;
    LAS bf16_t* Vt = (LAS bf16_t*)(lds + 384 * KP * 2);
    const int tid = fresh_tid(), lane = tid & 63, wv = tid >> 6, fr = lane & 15, g = lane >> 4;
    for (int it = blockIdx.x; it < 256; it += gridDim.x) {
        const int n = it >> 1, hk = it & 1, kbase = (n - 1) * 128;
        __syncthreads();
        {
            u32x4 kreg[6], va[3], vb[3];
#pragma unroll
            for (int q = 0; q < 6; ++q) { const int c = tid + q * NTHREADS, row = c >> 3, part = c & 7, s = kbase + row;
                kreg[q] = (u32x4){0u, 0u, 0u, 0u}; if (s >= 0 && s < SEQ) kreg[q] = *(const u32x4*)(proj + (size_t)s * NP + AK + hk * 64 + part * 8); }
#pragma unroll
            for (int q = 0; q < 3; ++q) { const int c = tid + q * NTHREADS, pr = c >> 3, part = c & 7, s = kbase + pr * 2;
                va[q] = (u32x4){0u, 0u, 0u, 0u}; vb[q] = (u32x4){0u, 0u, 0u, 0u};
                if (s >= 0 && s < SEQ) { va[q] = *(const u32x4*)(proj + (size_t)s * NP + AV + hk * 64 + part * 8); vb[q] = *(const u32x4*)(proj + (size_t)(s + 1) * NP + AV + hk * 64 + part * 8); } }
#pragma unroll
            for (int q = 0; q < 6; ++q) { const int c = tid + q * NTHREADS, row = c >> 3, part = c & 7; *(LAS u32x4*)(Ks + row * KP + part * 8) = kreg[q]; }
#pragma unroll
            for (int q = 0; q < 3; ++q) { const int c = tid + q * NTHREADS, pr = c >> 3, part = c & 7; const u32x4 a = va[q], b = vb[q];
#pragma unroll
                for (int e = 0; e < 4; ++e) {
                    *(LAS unsigned*)(Vt + (part * 8 + 2 * e) * VP + pr * 2) = (a[e] & 0xffffu) | (b[e] << 16);
                    *(LAS unsigned*)(Vt + (part * 8 + 2 * e + 1) * VP + pr * 2) = (a[e] >> 16) | (b[e] & 0xffff0000u); } }
        }
        const int hq = hk * 4 + (wv >> 1);
        bf16x8 qn[2];
#pragma unroll
        for (int ks = 0; ks < 2; ++ks) qn[ks] = *(const bf16x8*)(proj + (size_t)(n * 128 + (wv & 1) * 64 + fr) * NP + AQ + hq * 64 + ks * 32 + g * 8);
        __syncthreads();
        const float slope = exp2f(-(float)(hq + 1)), sink = p.attn_sink[l * 8 + hq];
        const bool edge = (n == 0) || (n == SEQ / 128 - 1);
        for (int tile = 0; tile < 4; ++tile) {
            const int tl = (wv & 1) * 64 + tile * 16 + fr, t = n * 128 + tl;
            bf16x8 qf[2];
#pragma unroll
            for (int ks = 0; ks < 2; ++ks) { qf[ks] = qn[ks]; qn[ks] = *(const bf16x8*)(proj + (size_t)(t + (tile < 3 ? 16 : 0)) * NP + AQ + hq * 64 + ks * 32 + g * 8); }
            f32x4 sacc[24];
#pragma unroll
            for (int kt = 0; kt < 24; ++kt) { f32x4 a = {0.f, 0.f, 0.f, 0.f};
#pragma unroll
                for (int ks = 0; ks < 2; ++ks) { const bf16x8 kf = *(const LAS bf16x8*)(Ks + (kt * 16 + fr) * KP + ks * 32 + g * 8); a = __builtin_amdgcn_mfma_f32_16x16x32_bf16(kf, qf[ks], a, 0, 0, 0); }
                sacc[kt] = a; if ((kt % 6) == 5) __builtin_amdgcn_sched_barrier(0); }
            const float tq = (float)(tl + 128 - 4 * g);
            float mx = sink;
#pragma unroll
            for (int kt = 0; kt < 24; ++kt)
#pragma unroll
                for (int r = 0; r < 4; ++r) { const float x = (float)(kt * 16 + r) - tq; float sc = fmaf(sacc[kt][r], 0.125f, -slope * fabsf(x));
                    bool valid = fabsf(x) <= 128.0f;
                    if (edge) { const int kl = kt * 16 + 4 * g + r; valid = valid && (n == 0 ? kl >= 128 : kl < 256); }
                    sc = valid ? sc : -1e30f; sacc[kt][r] = sc; mx = fmaxf(mx, sc); }
            mx = fmaxf(mx, __shfl_xor(mx, 16)); mx = fmaxf(mx, __shfl_xor(mx, 32));
            float sum = 0.f; const float mxl = mx * 1.44269504f;
#pragma unroll
            for (int kt = 0; kt < 24; ++kt)
#pragma unroll
                for (int r = 0; r < 4; ++r) { const float pr = exp2f(fmaf(sacc[kt][r], 1.44269504f, -mxl)); sacc[kt][r] = pr; sum += pr; }
            sum += __shfl_xor(sum, 16); sum += __shfl_xor(sum, 32);
            const float inv = 1.0f / (sum + __expf(sink - mx));
            f32x4 oacc[4];
#pragma unroll
            for (int dt = 0; dt < 4; ++dt) oacc[dt] = (f32x4){0.f, 0.f, 0.f, 0.f};
#pragma unroll
            for (int i = 0; i < 12; ++i) {
                u32x4 pw; pw.x = cvt_pk_bf16_mfma(sacc[2 * i][0], sacc[2 * i][1]); pw.y = cvt_pk_bf16_mfma(sacc[2 * i][2], sacc[2 * i][3]); pw.z = cvt_pk_bf16_mfma(sacc[2 * i + 1][0], sacc[2 * i + 1][1]); pw.w = cvt_pk_bf16_mfma(sacc[2 * i + 1][2], sacc[2 * i + 1][3]);
                const bf16x8 pf = __builtin_bit_cast(bf16x8, pw);
#pragma unroll
                for (int dt = 0; dt < 4; ++dt) { const LAS bf16_t* vp = Vt + (dt * 16 + fr) * VP + 32 * i + 4 * g;
                    const u32x2 lo = *(const LAS u32x2*)vp, hi = *(const LAS u32x2*)(vp + 16);
                    u32x4 vw; vw.x = lo.x; vw.y = lo.y; vw.z = hi.x; vw.w = hi.y;
                    oacc[dt] = __builtin_amdgcn_mfma_f32_16x16x32_bf16(__builtin_bit_cast(bf16x8, vw), pf, oacc[dt], 0, 0, 0); }
                if (i & 1) __builtin_amdgcn_sched_barrier(0); }
#pragma unroll
            for (int dt = 0; dt < 4; ++dt) { u32x2 w; w.x = cvt_pk_bf16(oacc[dt][0] * inv, oacc[dt][1] * inv); w.y = cvt_pk_bf16(oacc[dt][2] * inv, oacc[dt][3] * inv);
                *(u32x2*)(y0 + (size_t)t * 512 + hq * 64 + dt * 16 + 4 * g) = w; }
        }
    }
}
__device__ void conv_naive(const Params& p, int l, const bf16_t* proj, bf16_t* ycat) {
    for (int gidx = blockIdx.x * NTHREADS + fresh_tid(); gidx < (SEQ / 8) * 128; gidx += gridDim.x * NTHREADS) {
        const int tb = (gidx >> 7) * 8, c = (gidx & 127) * 4;
        u32x2 hh[10], cc[10], bb[8];
#pragma unroll
        for (int j = 0; j < 10; ++j) { const int ts = tb + j - 1; const bool ok = ts >= 0 && ts < SEQ; const int tc = ok ? ts : tb;
            hh[j] = *(const u32x2*)(proj + (size_t)tc * NP + CH + c); cc[j] = *(const u32x2*)(proj + (size_t)tc * NP + CC + c);
            if (!ok) { hh[j].x = 0u; hh[j].y = 0u; } }
#pragma unroll
        for (int j = 0; j < 8; ++j) bb[j] = *(const u32x2*)(proj + (size_t)(tb + j) * NP + CB + c);
        f32x4 w[3];
#pragma unroll
        for (int j = 0; j < 3; ++j) w[j] = *(const f32x4*)(p.conv_w + ((size_t)l * 3 + j) * 512 + c);
        f32x4 u[10];
#pragma unroll
        for (int j = 0; j < 10; ++j) { u[j][0] = bf_lo(hh[j].x) * bf_lo(cc[j].x); u[j][1] = bf_hi(hh[j].x) * bf_hi(cc[j].x); u[j][2] = bf_lo(hh[j].y) * bf_lo(cc[j].y); u[j][3] = bf_hi(hh[j].y) * bf_hi(cc[j].y); }
#pragma unroll
        for (int j = 0; j < 8; ++j) { const f32x4 a = w[0] * u[j] + w[1] * u[j + 1] + w[2] * u[j + 2];
            u32x2 o; o.x = cvt_pk_bf16(a[0] * bf_lo(bb[j].x), a[1] * bf_hi(bb[j].x)); o.y = cvt_pk_bf16(a[2] * bf_lo(bb[j].y), a[3] * bf_hi(bb[j].y));
            *(u32x2*)(ycat + (size_t)SEQ * 512 + (size_t)(tb + j) * 512 + c) = o; }
    }
}
constexpr int GP = 72;
constexpr int G_QT = 0, G_KT = 9216, G_KH = 18432, G_VT = 27648, G_PP = 46080, G_EBL = 55296, G_PART = 55552;
template <bool OUT>
__device__ __forceinline__ void gla_chunks(const Params& p, int l, const bf16_t* proj, LAS unsigned char* lds, int seg, int h, int dir, f32x4 (&Sacc)[4], float* outbuf, float& alog) {
    LAS bf16_t* QT = (LAS bf16_t*)(lds + G_QT); LAS bf16_t* KT = (LAS bf16_t*)(lds + G_KT); LAS bf16_t* KH = (LAS bf16_t*)(lds + G_KH);
    LAS bf16_t* VT = (LAS bf16_t*)(lds + G_VT); LAS bf16_t* PP = (LAS bf16_t*)(lds + G_PP); LAS float* EBL = (LAS float*)(lds + G_EBL); LAS float* PART = (LAS float*)(lds + G_PART);
    const int tid = fresh_tid(), lane = tid & 63, wv = __builtin_amdgcn_readfirstlane(tid >> 6), fr = lane & 15, g = lane >> 4;
    const int d = lane, tb = wv;
    const float* w2 = p.gw2 + ((size_t)(l * 2 + dir) * 16) * 256 + h * 64 + d; const float bias = p.gb[(l * 2 + dir) * 256 + h * 64 + d];
    float w[16];
#pragma unroll
    for (int r = 0; r < 16; ++r) w[r] = w2[r * 256];
    for (int c = 0; c < 4; ++c) {
        const int t0 = seg * SEGLEN + (dir ? 3 - c : c) * 64;
        float bq[8], qv[8], kv[8];
        { u32x4 L0[8], L1[8]; bf16_t kr[8], qr[8];
#pragma unroll
          for (int j = 0; j < 8; ++j) { const int i = tb * 8 + j, t = dir ? t0 + 63 - i : t0 + i;
              const u32x4* lr = (const u32x4*)(proj + (size_t)t * NP + GLR + dir * 16); L0[j] = lr[0]; L1[j] = lr[1];
              kr[j] = proj[(size_t)t * NP + GK + h * 64 + d]; qr[j] = OUT ? proj[(size_t)t * NP + GQ + h * 64 + d] : (bf16_t)0; }
          __builtin_amdgcn_sched_barrier(0);
          float run = 0.f;
#pragma unroll
          for (int j = 0; j < 8; ++j) { const u32x4 l0 = L0[j], l1 = L1[j]; float z = bias;
#pragma unroll
              for (int e = 0; e < 4; ++e) { z += bf_lo(l0[e]) * w[e * 2] + bf_hi(l0[e]) * w[e * 2 + 1]; z += bf_lo(l1[e]) * w[8 + e * 2] + bf_hi(l1[e]) * w[8 + e * 2 + 1]; }
              const float ls = fminf(z, 0.f) - __logf(1.0f + __expf(-fabsf(z)));
              run += ls * (1.0f / 16.0f); bq[j] = run;
              kv[j] = bf2f(kr[j]);
              if (OUT) qv[j] = bf2f(qr[j]) * 0.125f; }
          PART[tb * 64 + d] = run; }
        { const int pr = tid >> 4, part = tid & 15; const int i0 = 2 * pr, ta = dir ? t0 + 63 - i0 : t0 + i0, tbb = dir ? ta - 1 : ta + 1;
          const u32x4 a = *(const u32x4*)(proj + (size_t)ta * NP + GV + h * 128 + part * 8), b = *(const u32x4*)(proj + (size_t)tbb * NP + GV + h * 128 + part * 8);
#pragma unroll
          for (int e = 0; e < 4; ++e) {
              *(LAS unsigned*)(VT + (part * 8 + 2 * e) * GP + i0) = (a[e] & 0xffffu) | (b[e] << 16);
              *(LAS unsigned*)(VT + (part * 8 + 2 * e + 1) * GP + i0) = (a[e] >> 16) | (b[e] & 0xffff0000u); } }
        __syncthreads();
        { float off = 0.f, tot = 0.f;
#pragma unroll
          for (int q = 0; q < 8; ++q) { const float v = PART[q * 64 + d]; tot += v; if (q < tb) off += v; }
          if (tb == 0) { EBL[d] = __expf(tot); alog += tot; }
          unsigned kh[4];
#pragma unroll
          for (int j = 0; j < 8; j += 2) { const float b0 = bq[j] + off, b1 = bq[j + 1] + off;
              const int i = tb * 8 + j;
              if (OUT) { QT[i * GP + d] = (bf16_t)(cvt_pk_bf16(qv[j] * __expf(b0), 0.f) & 0xffffu); QT[(i + 1) * GP + d] = (bf16_t)(cvt_pk_bf16(qv[j + 1] * __expf(b1), 0.f) & 0xffffu);
                         KT[i * GP + d] = (bf16_t)(cvt_pk_bf16(kv[j] * __expf(-b0), 0.f) & 0xffffu); KT[(i + 1) * GP + d] = (bf16_t)(cvt_pk_bf16(kv[j + 1] * __expf(-b1), 0.f) & 0xffffu); }
              kh[j >> 1] = cvt_pk_bf16(kv[j] * __expf(tot - b0), kv[j + 1] * __expf(tot - b1)); }
          u32x4 kw; kw.x = kh[0]; kw.y = kh[1]; kw.z = kh[2]; kw.w = kh[3];
          *(LAS u32x4*)(KH + d * GP + tb * 8) = kw; }
        __syncthreads();
        if (OUT) {
#pragma unroll
            for (int q = 0; q < 2; ++q) { const int tt = 2 * wv + q, jt = tt >> 2, it = tt & 3;
                f32x4 a = {0.f, 0.f, 0.f, 0.f};
                if (it >= jt) {
#pragma unroll
                    for (int ks = 0; ks < 2; ++ks) { const bf16x8 kf = *(const LAS bf16x8*)(KT + (jt * 16 + fr) * GP + ks * 32 + g * 8), qf = *(const LAS bf16x8*)(QT + (it * 16 + fr) * GP + ks * 32 + g * 8);
                        a = __builtin_amdgcn_mfma_f32_16x16x32_bf16(kf, qf, a, 0, 0, 0); }
                    const int i = it * 16 + fr, j0 = jt * 16 + 4 * g;
#pragma unroll
                    for (int r = 0; r < 4; ++r) if (j0 + r > i) a[r] = 0.f; }
                u32x2 pw; pw.x = cvt_pk_bf16(a[0], a[1]); pw.y = cvt_pk_bf16(a[2], a[3]);
                *(LAS u32x2*)(PP + (it * 16 + fr) * GP + jt * 16 + 4 * g) = pw; }
            __syncthreads();
        }
        bf16x8 bv[2];
#pragma unroll
        for (int ks = 0; ks < 2; ++ks) bv[ks] = *(const LAS bf16x8*)(VT + (16 * wv + fr) * GP + 32 * ks + 8 * g);
        if (OUT) {
            bf16x8 bs[2];
#pragma unroll
            for (int m = 0; m < 2; ++m) { u32x4 sw; sw.x = cvt_pk_bf16_mfma(Sacc[2 * m][0], Sacc[2 * m][1]); sw.y = cvt_pk_bf16_mfma(Sacc[2 * m][2], Sacc[2 * m][3]); sw.z = cvt_pk_bf16_mfma(Sacc[2 * m + 1][0], Sacc[2 * m + 1][1]); sw.w = cvt_pk_bf16_mfma(Sacc[2 * m + 1][2], Sacc[2 * m + 1][3]); bs[m] = __builtin_bit_cast(bf16x8, sw); }
#pragma unroll
            for (int it = 0; it < 4; ++it) { f32x4 o = {0.f, 0.f, 0.f, 0.f};
#pragma unroll
                for (int ks = 0; ks < 2; ++ks) { const bf16x8 pf = *(const LAS bf16x8*)(PP + (it * 16 + fr) * GP + 32 * ks + 8 * g); o = __builtin_amdgcn_mfma_f32_16x16x32_bf16(pf, bv[ks], o, 0, 0, 0); }
#pragma unroll
                for (int m = 0; m < 2; ++m) { const LAS bf16_t* qp = QT + (it * 16 + fr) * GP + 32 * m + 4 * g; const u32x2 lo = *(const LAS u32x2*)qp, hi = *(const LAS u32x2*)(qp + 16);
                    u32x4 qw; qw.x = lo.x; qw.y = lo.y; qw.z = hi.x; qw.w = hi.y; o = __builtin_amdgcn_mfma_f32_16x16x32_bf16(__builtin_bit_cast(bf16x8, qw), bs[m], o, 0, 0, 0); }
#pragma unroll
                for (int r = 0; r < 4; ++r) { const int i = it * 16 + 4 * g + r, t = dir ? t0 + 63 - i : t0 + i; outbuf[(size_t)t * 512 + h * 128 + 16 * wv + fr] = o[r]; } }
        }
#pragma unroll
        for (int dt = 0; dt < 4; ++dt) { const f32x4 eb = *(const LAS f32x4*)(EBL + dt * 16 + 4 * g); f32x4 a = Sacc[dt] * eb;
#pragma unroll
            for (int ks = 0; ks < 2; ++ks) { const bf16x8 kf = *(const LAS bf16x8*)(KH + (dt * 16 + fr) * GP + 32 * ks + 8 * g); a = __builtin_amdgcn_mfma_f32_16x16x32_bf16(kf, bv[ks], a, 0, 0, 0); }
            Sacc[dt] = a; }
        __syncthreads();
    }
}
__device__ void gla_pass1(const Params& p, int l, const bf16_t* proj, LAS unsigned char* lds) {
    float* GE = (float*)(p.ws + WS_GE); float* GA = (float*)(p.ws + WS_GASEG);
    for (int it = blockIdx.x; it < NSEG * 8; it += gridDim.x) {
        const int seg = it >> 3, h = (it >> 1) & 3, dir = it & 1;
        const int tid = fresh_tid(), lane = tid & 63, wv = tid >> 6, fr = lane & 15, g = lane >> 4;
        f32x4 Sacc[4];
#pragma unroll
        for (int dt = 0; dt < 4; ++dt) Sacc[dt] = (f32x4){0.f, 0.f, 0.f, 0.f};
        float alog = 0.f;
        gla_chunks<false>(p, l, proj, lds, seg, h, dir, Sacc, nullptr, alog);
        const size_t base = (size_t)(seg * 2 + dir) * 32768 + (size_t)h * 8192;
#pragma unroll
        for (int dt = 0; dt < 4; ++dt)
#pragma unroll
            for (int r = 0; r < 4; ++r) GE[base + (size_t)(dt * 16 + 4 * g + r) * 128 + 16 * wv + fr] = Sacc[dt][r];
        if (tid < 64) GA[((seg * 2 + dir) * 4 + h) * 64 + tid] = __expf(alog);
    }
}
__device__ void gla_scan(const Params& p) {
    const float* GE = (const float*)(p.ws + WS_GE); const float* GA = (const float*)(p.ws + WS_GASEG); float* GS = (float*)(p.ws + WS_GSIN);
    for (int g = blockIdx.x * NTHREADS + fresh_tid(); g < 65536; g += gridDim.x * NTHREADS) {
        const int dir = g >> 15, r = g & 32767, h = r >> 13, d = (r >> 7) & 63;
        float S = 0.f;
        for (int i0 = 0; i0 < NSEG; i0 += 8) { float ea[8], aa[8];
#pragma unroll
            for (int q = 0; q < 8; ++q) { const int seg = dir ? NSEG - 1 - (i0 + q) : i0 + q; ea[q] = GE[(size_t)(seg * 2 + dir) * 32768 + r]; aa[q] = GA[((seg * 2 + dir) * 4 + h) * 64 + d]; }
#pragma unroll
            for (int q = 0; q < 8; ++q) { const int seg = dir ? NSEG - 1 - (i0 + q) : i0 + q; GS[(size_t)(seg * 2 + dir) * 32768 + r] = S; S = aa[q] * S + ea[q]; } }
    }
}
__device__ void gla_pass2(const Params& p, int l, const bf16_t* proj, bf16_t* ycat, LAS unsigned char* lds) {
    const float* GS = (const float*)(p.ws + WS_GSIN); float* OF = (float*)(p.ws + WS_OF); float* OB = (float*)(p.ws + WS_OF2);
    for (int it = blockIdx.x; it < NSEG * 4; it += gridDim.x) {
        const int seg = it >> 2, h = it & 3;
        const int tid = fresh_tid(), lane = tid & 63, wv = tid >> 6, fr = lane & 15, g = lane >> 4;
        for (int dir = 0; dir < 2; ++dir) {
            f32x4 Sacc[4];
            const size_t base = (size_t)(seg * 2 + dir) * 32768 + (size_t)h * 8192;
#pragma unroll
            for (int dt = 0; dt < 4; ++dt)
#pragma unroll
                for (int r = 0; r < 4; ++r) Sacc[dt][r] = GS[base + (size_t)(dt * 16 + 4 * g + r) * 128 + 16 * wv + fr];
            float alog = 0.f;
            gla_chunks<true>(p, l, proj, lds, seg, h, dir, Sacc, dir ? OB : OF, alog);
        }
        __syncthreads();
        const f32x2 gg = *(const f32x2*)(p.gng + l * 512 + h * 128 + lane * 2);
        for (int j0 = 0; j0 < 32; j0 += 8) {
            f32x2 of[8], ob[8]; unsigned rw[8];
#pragma unroll
            for (int j = 0; j < 8; ++j) { const int t = seg * SEGLEN + wv * 32 + j0 + j; const size_t oo = (size_t)t * 512 + h * 128 + lane * 2;
                of[j] = *(const f32x2*)(OF + oo); ob[j] = *(const f32x2*)(OB + oo); rw[j] = *(const unsigned*)(proj + (size_t)t * NP + GR + h * 128 + lane * 2); }
#pragma unroll
            for (int j = 0; j < 8; ++j) { const int t = seg * SEGLEN + wv * 32 + j0 + j;
                const float o0 = of[j][0] + ob[j][0], o1 = of[j][1] + ob[j][1];
                const float ss = wave_sum(o0 * o0 + o1 * o1);
                const float rs = rsqrtf(ss * (1.0f / 128.0f) + 1e-6f);
                const float r0 = bf_lo(rw[j]), r1 = bf_hi(rw[j]);
                const float y0 = o0 * rs * gg[0] * (r0 / (1.0f + __expf(-r0))), y1 = o1 * rs * gg[1] * (r1 / (1.0f + __expf(-r1)));
                *(unsigned*)(ycat + (size_t)2 * SEQ * 512 + (size_t)t * 512 + h * 128 + lane * 2) = cvt_pk_bf16(y0, y1); } }
        __syncthreads();
    }
}

constexpr int RWP = 1028;
__device__ void phase_ln1_router(const Params& p, int l, LAS unsigned char* lds) {
    LAS float* rw_s = (LAS float*)lds;
    const int tid = fresh_tid(), lane = tid & 63, wv = tid >> 6;
    const float* rw = p.router_w + (size_t)l * DM * NE;
    for (int i0 = 0; i0 < DM * NE; i0 += 8 * NTHREADS) { float rr[8];
#pragma unroll
        for (int q = 0; q < 8; ++q) rr[q] = rw[i0 + q * NTHREADS + tid];
#pragma unroll
        for (int q = 0; q < 8; ++q) { const int i = i0 + q * NTHREADS + tid, d = i >> 4, e = i & 15; rw_s[e * RWP + d] = rr[q]; } }
    __syncthreads();
    const bf16_t* XP = (const bf16_t*)(p.ws + WS_XA); bf16_t* XB = (bf16_t*)(p.ws + WS_XB); float* AFF = (float*)(p.ws + WS_AFF);
    const float* g = p.ln_mix_g + l * DM; const float* b = p.ln_mix_b + l * DM;
    f32x4 gv[4], bv[4];
#pragma unroll
    for (int j = 0; j < 4; ++j) { gv[j] = *(const f32x4*)(g + lane * 4 + 256 * j); bv[j] = *(const f32x4*)(b + lane * 4 + 256 * j); }
    const int rstride = gridDim.x * 8;
    u32x2 raw[4];
    { const int row0 = blockIdx.x * 8 + wv;
      if (row0 < SEQ) {
#pragma unroll
          for (int j = 0; j < 4; ++j) raw[j] = *(const u32x2*)(XP + (size_t)row0 * DM + lane * 4 + 256 * j); } }
    for (int row = blockIdx.x * 8 + wv; row < SEQ; row += rstride) {
        f32x4 v[4]; float s = 0.f;
#pragma unroll
        for (int j = 0; j < 4; ++j) { const u32x2 w = raw[j]; v[j] = (f32x4){bf_lo(w.x), bf_hi(w.x), bf_lo(w.y), bf_hi(w.y)}; s += (v[j][0] + v[j][1]) + (v[j][2] + v[j][3]); }
        if (row + rstride < SEQ) {
#pragma unroll
            for (int j = 0; j < 4; ++j) raw[j] = *(const u32x2*)(XP + (size_t)(row + rstride) * DM + lane * 4 + 256 * j); }
        const float mean = wave_sum(s) * (1.0f / 1024.0f); float q = 0.f;
#pragma unroll
        for (int j = 0; j < 4; ++j) { v[j] = v[j] - mean; q += (v[j][0] * v[j][0] + v[j][1] * v[j][1]) + (v[j][2] * v[j][2] + v[j][3] * v[j][3]); }
        const float rstd = rsqrtf(wave_sum(q) * (1.0f / 1024.0f) + 1e-5f);
#pragma unroll
        for (int j = 0; j < 4; ++j) { v[j] = v[j] * rstd * gv[j] + bv[j];
            u32x2 w; w.x = cvt_pk_bf16(v[j][0], v[j][1]); w.y = cvt_pk_bf16(v[j][2], v[j][3]); *(u32x2*)(XB + (size_t)row * DM + lane * 4 + 256 * j) = w; }
        float a16[16];
#pragma unroll
        for (int e = 0; e < 16; ++e) { float a = 0.f;
#pragma unroll
            for (int j = 0; j < 4; ++j) { const f32x4 w = *(const LAS f32x4*)(rw_s + e * RWP + lane * 4 + 256 * j); a += v[j][0] * w[0] + v[j][1] * w[1] + v[j][2] * w[2] + v[j][3] * w[3]; }
            a16[e] = a; }
        float b8[8], c4[4], d2[2];
        { const bool hi = (lane & 32) != 0;
#pragma unroll
          for (int i = 0; i < 8; ++i) { const float keep = hi ? a16[8 + i] : a16[i], send = hi ? a16[i] : a16[8 + i]; b8[i] = keep + __shfl_xor(send, 32); } }
        { const bool hi = (lane & 16) != 0;
#pragma unroll
          for (int i = 0; i < 4; ++i) { const float keep = hi ? b8[4 + i] : b8[i], send = hi ? b8[i] : b8[4 + i]; c4[i] = keep + __shfl_xor(send, 16); } }
        { const bool hi = (lane & 8) != 0;
#pragma unroll
          for (int i = 0; i < 2; ++i) { const float keep = hi ? c4[2 + i] : c4[i], send = hi ? c4[i] : c4[2 + i]; d2[i] = keep + __shfl_xor(send, 8); } }
        float lgt; { const bool hi = (lane & 4) != 0; const float keep = hi ? d2[1] : d2[0], send = hi ? d2[0] : d2[1]; lgt = keep + __shfl_xor(send, 4); }
        lgt += __shfl_xor(lgt, 2); lgt += __shfl_xor(lgt, 1);
        float mx = lgt;
        mx = fmaxf(mx, __shfl_xor(mx, 4)); mx = fmaxf(mx, __shfl_xor(mx, 8)); mx = fmaxf(mx, __shfl_xor(mx, 16)); mx = fmaxf(mx, __shfl_xor(mx, 32));
        const float ex = expf(lgt - mx);
        float den = ex; den += __shfl_xor(den, 4); den += __shfl_xor(den, 8); den += __shfl_xor(den, 16); den += __shfl_xor(den, 32);
        const int eidx = ((lane >> 5) & 1) * 8 + ((lane >> 4) & 1) * 4 + ((lane >> 3) & 1) * 2 + ((lane >> 2) & 1);
        if ((lane & 3) == 0) AFF[(size_t)eidx * SEQ + row] = ex / den;
    }
}
__device__ void phase_topk(const Params& p, int l, LAS unsigned char* lds) {
    if (blockIdx.x >= NE) {
        if (l == 1 && gridDim.x > NE) cvt_job((LAS float*)lds, p.ewg + (size_t)NE * FF * 1024, (bf16_t*)(p.ws + WS_WG) + (size_t)NE * FF * 1024, NE, 1024, FF, 1024, 0, (size_t)1024 * FF, (size_t)FF * 1024, (int)blockIdx.x - NE, (int)gridDim.x - NE);
        if (l == 0 && gridDim.x > NE) cvt_job((LAS float*)lds, p.ewd + (size_t)NE * FF * 1024, (bf16_t*)(p.ws + WS_WD) + (size_t)NE * FF * 1024, NE, FF, 1024, FF, 0, (size_t)FF * 1024, (size_t)1024 * FF, (int)blockIdx.x - NE, (int)gridDim.x - NE);
        return; }
    const int e = blockIdx.x, tid = fresh_tid(), lane = tid & 63;
    LAS unsigned* keys = (LAS unsigned*)lds;
    LAS unsigned* hist = keys + SEQ;
    LAS unsigned* ctl = hist + 256;
    const unsigned* aff = (const unsigned*)(p.ws + WS_AFF) + (size_t)e * SEQ;
    int* IDX = (int*)(p.ws + WS_IDX) + e * CAP; float* GATEV = (float*)(p.ws + WS_GATEV) + e * CAP; int* SLOTOF = (int*)(p.ws + WS_SLOTOF);
    for (int i0 = 0; i0 < SEQ; i0 += 8 * NTHREADS) { unsigned kk[8];
#pragma unroll
        for (int q = 0; q < 8; ++q) kk[q] = aff[i0 + q * NTHREADS + tid];
#pragma unroll
        for (int q = 0; q < 8; ++q) keys[i0 + q * NTHREADS + tid] = kk[q]; }
    unsigned prefix = 0, krem = CAP;
    for (int pass = 0; pass < 4; ++pass) {
        const int shift = 24 - 8 * pass;
        if (tid < 256) hist[tid] = 0;
        __syncthreads();
        for (int i = tid; i < SEQ; i += NTHREADS) { const unsigned k = keys[i]; if (pass == 0 || (k >> (shift + 8)) == prefix) __hip_atomic_fetch_add(&hist[(k >> shift) & 255], 1u, __ATOMIC_RELAXED, __HIP_MEMORY_SCOPE_WORKGROUP); }
        __syncthreads();
        if (tid < 64) {
            unsigned c[4], tot = 0;
#pragma unroll
            for (int q = 0; q < 4; ++q) { c[q] = hist[255 - 4 * lane - q]; tot += c[q]; }
            unsigned incl = tot;
#pragma unroll
            for (int o = 1; o < 64; o <<= 1) { const unsigned n = __shfl_up(incl, o); if (lane >= o) incl += n; }
            const unsigned excl = incl - tot;
            if (excl < krem && krem <= incl) { unsigned run = excl;
#pragma unroll
                for (int q = 0; q < 4; ++q) { if (run < krem && krem <= run + c[q]) { ctl[0] = 255 - 4 * lane - q; ctl[1] = krem - run; ctl[3] = c[q]; } run += c[q]; } }
        }
        __syncthreads();
        prefix = (prefix << 8) | ctl[0]; krem = ctl[1];
        __syncthreads();
    }
    const unsigned T = prefix; const unsigned n_eq = ctl[3]; const bool all_eq = (n_eq == krem); const unsigned cnt_gt = CAP - krem;
    if (tid == 0) ctl[2] = 0;
    __syncthreads();
    for (int i = tid; i < SEQ; i += NTHREADS) { const unsigned k = keys[i];
        if (k > T || (k == T && all_eq)) { const unsigned slot = __hip_atomic_fetch_add(&ctl[2], 1u, __ATOMIC_RELAXED, __HIP_MEMORY_SCOPE_WORKGROUP); IDX[slot] = i; GATEV[slot] = __uint_as_float(k); SLOTOF[i * NE + e] = e * CAP + (int)slot; }
        else if (k != T) SLOTOF[i * NE + e] = -1; }
    __syncthreads();
    if (!all_eq && tid == 0) { unsigned r = 0;
        for (int i = 0; i < SEQ; ++i) if (keys[i] == T) { if (r < krem) { const unsigned slot = cnt_gt + r; IDX[slot] = i; GATEV[slot] = __uint_as_float(T); SLOTOF[i * NE + e] = e * CAP + (int)slot; ++r; } else SLOTOF[i * NE + e] = -1; } }
}
__device__ void phase_combine(const Params& p, int l, float* outp) {
    const int tid = fresh_tid(), lane = tid & 63, wv = tid >> 6;
    bf16_t* XB = (bf16_t*)(p.ws + WS_XB); const bf16_t* YB = (const bf16_t*)(p.ws + WS_YB); const int* SLOTOF = (const int*)(p.ws + WS_SLOTOF);
    const float* g = p.ln_ffn_g + l * DM; const float* b = p.ln_ffn_b + l * DM;
    f32x4 gv[4], bv[4];
#pragma unroll
    for (int j = 0; j < 4; ++j) { gv[j] = *(const f32x4*)(g + lane * 4 + 256 * j); bv[j] = *(const f32x4*)(b + lane * 4 + 256 * j); }
    const int rstride = gridDim.x * 8;
    int nslot = 0; u32x2 nraw[4];
    { const int row0 = blockIdx.x * 8 + wv;
      if (row0 < SEQ) { nslot = SLOTOF[row0 * NE + (lane & 15)];
#pragma unroll
          for (int j = 0; j < 4; ++j) nraw[j] = *(const u32x2*)(XB + (size_t)row0 * DM + lane * 4 + 256 * j); } }
    for (int row = blockIdx.x * 8 + wv; row < SEQ; row += rstride) {
        f32x4 v[4];
        const int myslot = nslot;
#pragma unroll
        for (int j = 0; j < 4; ++j) { const u32x2 w = nraw[j]; v[j] = (f32x4){bf_lo(w.x), bf_hi(w.x), bf_lo(w.y), bf_hi(w.y)} * ALPHA; }
        if (row + rstride < SEQ) { nslot = SLOTOF[(row + rstride) * NE + (lane & 15)];
#pragma unroll
            for (int j = 0; j < 4; ++j) nraw[j] = *(const u32x2*)(XB + (size_t)(row + rstride) * DM + lane * 4 + 256 * j); }
        unsigned long long em = __ballot(myslot >= 0) & 0xffffull;
        while (em) {
            int sl[4];
#pragma unroll
            for (int k = 0; k < 4; ++k) { sl[k] = -1; if (em) { const int e = __builtin_ctzll(em); em &= em - 1; sl[k] = __builtin_amdgcn_readlane(myslot, e); } }
            u32x2 yw[4][4];
#pragma unroll
            for (int k = 0; k < 4; ++k) if (sl[k] >= 0) {
#pragma unroll
                for (int j = 0; j < 4; ++j) yw[k][j] = *(const u32x2*)(YB + (size_t)sl[k] * DM + lane * 4 + 256 * j); }
#pragma unroll
            for (int k = 0; k < 4; ++k) if (sl[k] >= 0) {
#pragma unroll
                for (int j = 0; j < 4; ++j) { const u32x2 w = yw[k][j]; v[j][0] += bf_lo(w.x); v[j][1] += bf_hi(w.x); v[j][2] += bf_lo(w.y); v[j][3] += bf_hi(w.y); } }
        }
        float s = 0.f;
#pragma unroll
        for (int j = 0; j < 4; ++j) s += (v[j][0] + v[j][1]) + (v[j][2] + v[j][3]);
        const float mean = wave_sum(s) * (1.0f / 1024.0f); float q = 0.f;
#pragma unroll
        for (int j = 0; j < 4; ++j) { v[j] = v[j] - mean; q += (v[j][0] * v[j][0] + v[j][1] * v[j][1]) + (v[j][2] * v[j][2] + v[j][3] * v[j][3]); }
        const float rstd = rsqrtf(wave_sum(q) * (1.0f / 1024.0f) + 1e-5f);
#pragma unroll
        for (int j = 0; j < 4; ++j) { v[j] = v[j] * rstd * gv[j] + bv[j];
            if (l == NL - 1) *(f32x4*)(outp + (size_t)row * DM + lane * 4 + 256 * j) = v[j];
            else { u32x2 w; w.x = cvt_pk_bf16(v[j][0], v[j][1]); w.y = cvt_pk_bf16(v[j][2], v[j][3]); *(u32x2*)(XB + (size_t)row * DM + lane * 4 + 256 * j) = w; } }
    }
}

constexpr int PH_PER_LAYER = 11, N_PHASES = 1 + NL * PH_PER_LAYER;

__device__ __forceinline__ void run_phase(const Params& p, int ph, LAS unsigned char* lds) {
    unsigned char* ws = p.ws;
    if (ph == 0) { phase_convert(p, lds); return; }
    const int l = (ph - 1) / PH_PER_LAYER, k = (ph - 1) % PH_PER_LAYER;
    bf16_t* PROJ = (bf16_t*)(ws + WS_PROJ); bf16_t* YCAT = (bf16_t*)(ws + WS_YCAT);
    switch (k) {
    case 0: {
        Sched S; S.A = (const char*)(ws + WS_XB); S.idx = nullptr; S.B0 = (const char*)(ws + WS_WIN) + (size_t)l * NP * 1024 * 2; S.b1off = (size_t)HALF * 1024 * 2; S.bstrideE = 0; S.bRowsPerPn = 256; S.K = 1024; S.init(SEQ / BM, NP / BM);
        EpiProj E{PROJ, (u32x4*)(ws + WS_GT)}; gemm_phase<false>(lds, S, E); } break;
    case 1: { attn_mfma(p, l, PROJ, YCAT, lds); conv_naive(p, l, PROJ, YCAT); __syncthreads(); gla_pass1(p, l, PROJ, lds); } break;
    case 2: gla_scan(p); break;
    case 3: gla_pass2(p, l, PROJ, YCAT, lds); break;
    case 4: {
        Sched S; S.A = (const char*)YCAT; S.idx = nullptr; S.B0 = (const char*)(ws + WS_WMRG) + (size_t)l * 3 * 1024 * 512 * 2; S.b1off = (size_t)HALF * 512 * 2; S.bstrideE = 0; S.bRowsPerPn = 256; S.K = 512; S.init(SEQ / BM, DM / BM);
        S.nbr = 3; S.abr = (size_t)SEQ * 512 * 2; S.bbr = (size_t)1024 * 512 * 2;
        EpiMerge E{(const u32x4*)(ws + WS_GT), (bf16_t*)(ws + WS_MERGED)}; gemm_phase<false>(lds, S, E); } break;
    case 5: {
        Sched S; S.A = (const char*)(ws + WS_MERGED); S.idx = nullptr; S.B0 = (const char*)(ws + WS_WOUT) + (size_t)l * 1024 * 1024 * 2; S.b1off = (size_t)HALF * 1024 * 2; S.bstrideE = 0; S.bRowsPerPn = 256; S.K = 1024; S.init(SEQ / BM, DM / BM);
        EpiWout E{(const bf16_t*)(ws + WS_XB), (bf16_t*)(ws + WS_XA)}; gemm_phase<false>(lds, S, E); } break;
    case 6: phase_ln1_router(p, l, lds); break;
    case 7: phase_topk(p, l, lds); break;
    case 8: {
        Sched S; S.A = (const char*)(ws + WS_XB); S.idx = (const int*)(ws + WS_IDX); S.B0 = (const char*)(ws + WS_WG) + (size_t)l * NE * FF * 1024 * 2; S.b1off = WS_WU - WS_WG;
        S.bstrideE = (size_t)FF * 1024 * 2; S.bRowsPerPn = 128; S.K = 1024; S.init(NSLOT / BM, FF / HALF);
        EpiMoe1 E{(bf16_t*)(ws + WS_H)}; gemm_phase<true>(lds, S, E); } break;
    case 9: {
        Sched S; S.A = (const char*)(ws + WS_H); S.idx = nullptr; S.B0 = (const char*)(ws + WS_WD) + (size_t)l * NE * FF * 1024 * 2; S.b1off = (size_t)HALF * FF * 2;
        S.bstrideE = (size_t)FF * 1024 * 2; S.bRowsPerPn = 256; S.K = FF; S.init(NSLOT / BM, DM / BM);
        EpiMoe2 E{(const float*)(ws + WS_GATEV), (bf16_t*)(ws + WS_YB)}; gemm_phase<false>(lds, S, E); } break;
    case 10: phase_combine(p, l, p.out); break;
    }
}

__device__ __forceinline__ void grid_barrier(unsigned* ctl, unsigned k) {
    asm volatile("s_waitcnt vmcnt(0)" ::: "memory");
    __syncthreads();
    if (threadIdx.x == 0) {
        const unsigned g = blockIdx.x & 7u, G = gridDim.x, members = (G - g + 7u) >> 3, ngroups = G < 8u ? G : 8u;
        __builtin_amdgcn_fence(__ATOMIC_RELEASE, "agent");
        asm volatile("s_waitcnt vmcnt(0)" ::: "memory");
        const unsigned old = __hip_atomic_fetch_add(ctl + 32 * g, 1u, __ATOMIC_RELAXED, __HIP_MEMORY_SCOPE_AGENT);
        if (old == k * members - 1u) {
            const unsigned old2 = __hip_atomic_fetch_add(ctl + 256, 1u, __ATOMIC_RELAXED, __HIP_MEMORY_SCOPE_AGENT);
            if (old2 == k * ngroups - 1u) {
                for (unsigned q = 0; q < ngroups; ++q) __hip_atomic_store(ctl + 512 + 32 * q, k, __ATOMIC_RELAXED, __HIP_MEMORY_SCOPE_AGENT);
            }
        }
        while (__hip_atomic_load(ctl + 512 + 32 * g, __ATOMIC_RELAXED, __HIP_MEMORY_SCOPE_AGENT) < k) __builtin_amdgcn_s_sleep(1);
        __builtin_amdgcn_fence(__ATOMIC_ACQUIRE, "agent");
        asm volatile("s_waitcnt vmcnt(0)" ::: "memory");
    }
    __syncthreads();
}
__global__ void __launch_bounds__(NTHREADS, 2) mega(Params p) {
    extern __shared__ __attribute__((aligned(16))) unsigned char lds_raw[];
    LAS unsigned char* lds = (LAS unsigned char*)lds_raw;
    cg::grid_group grid = cg::this_grid();
    for (int ph = p.ph_lo; ph < p.ph_hi; ++ph) {
        if (ph > p.ph_lo) { if (p.ph_hi > 4096) grid.sync();   else grid_barrier((unsigned*)p.ws, (unsigned)(ph - p.ph_lo)); }
#ifdef DUPMASK
        { const int kk = ph == 0 ? 11 : (ph - 1) % PH_PER_LAYER; if ((DUPMASK >> kk) & 1) { run_phase(p, ph, lds); __syncthreads(); } }
#endif
        run_phase(p, ph, lds);
    }
}
}

extern "C" void kernel_launch(void* const* d_in, const int* in_sizes, int n_in, void* d_out, int out_size, void* d_ws, size_t ws_size, hipStream_t stream) {
    static int grid = 0;
    if (grid == 0) {
        if (n_in != 19 || out_size != SEQ * DM || ws_size < WS_END) { fprintf(stderr, "kernel_launch: unexpected shapes: n_in %d out %d ws %zu (need %zu)\n", n_in, out_size, ws_size, (size_t)WS_END); grid = -1; return; }
        int dev = 0, cus = 0, per_cu = 0;
        hipGetDevice(&dev); hipDeviceGetAttribute(&cus, hipDeviceAttributeMultiprocessorCount, dev);
        if (hipFuncSetAttribute((const void*)mega, hipFuncAttributeMaxDynamicSharedMemorySize, LDS_BYTES) != hipSuccess) { fprintf(stderr, "kernel_launch: hipFuncSetAttribute failed\n"); grid = -1; return; }
        if (hipOccupancyMaxActiveBlocksPerMultiprocessor(&per_cu, (const void*)mega, NTHREADS, LDS_BYTES) != hipSuccess || per_cu < 1) { fprintf(stderr, "kernel_launch: occupancy query failed (%d)\n", per_cu); per_cu = 1; }
        (void)hipGetLastError();
        grid = cus * 1;
    }
    if (grid < 0) return;
    Params p{};
    p.x = (const float*)d_in[0]; p.w_in = (const float*)d_in[1]; p.attn_sink = (const float*)d_in[2]; p.conv_w = (const float*)d_in[3]; p.gw2 = (const float*)d_in[4]; p.gb = (const float*)d_in[5]; p.gng = (const float*)d_in[6];
    p.wba = (const float*)d_in[7]; p.wbc = (const float*)d_in[8]; p.wbg = (const float*)d_in[9]; p.w_out = (const float*)d_in[10]; p.ln_mix_g = (const float*)d_in[11]; p.ln_mix_b = (const float*)d_in[12];
    p.router_w = (const float*)d_in[13]; p.ewg = (const float*)d_in[14]; p.ewu = (const float*)d_in[15]; p.ewd = (const float*)d_in[16]; p.ln_ffn_g = (const float*)d_in[17]; p.ln_ffn_b = (const float*)d_in[18];
    p.out = (float*)d_out; p.ws = (unsigned char*)d_ws;
#if ONE_LAUNCH
    p.ph_lo = 0; p.ph_hi = N_PHASES;
    (void)hipMemsetAsync(d_ws, 0, 4096, stream);
    void* args[] = {&p};
    hipError_t e = hipLaunchCooperativeKernel((const void*)mega, dim3(grid), dim3(NTHREADS), args, LDS_BYTES, stream);
    if (e != hipSuccess) fprintf(stderr, "cooperative launch failed: %s (grid %d)\n", hipGetErrorString(e), grid);
#else
    for (int ph = 0; ph < N_PHASES; ++ph) { p.ph_lo = ph; p.ph_hi = ph + 1; hipLaunchKernelGGL(mega, dim3(grid), dim3(NTHREADS), LDS_BYTES, stream, p); }
#endif
}
```
